# Optimizing an MI355X kernel written in HIP

```python
import math
import jax, jax.numpy as jnp
from jax import lax
import numpy as np

D_MODEL = 1024
BATCH = 8
SEQ = 2048
DEPTH = 2
DEC_BATCH = 128
DEC_SEQ = 1
PAST_LEN = 16384
PAGE_SIZE = 128

A_WIDTH = D_MODEL * 3 // 8
A_DK = 64
A_DV = 64
A_HEADS = A_WIDTH // A_DK
B_WIDTH = D_MODEL * 3 // 8
B_DV = 64
B_HEADS = B_WIDTH // B_DV
B_DK = B_DV // 2
B_QK = B_HEADS * B_DK
GLA_RANK = 16
GLA_TAU = 16.0
C_WIDTH = D_MODEL - A_WIDTH - B_WIDTH
C_GROUP = 16
C_GROUPS = C_WIDTH // C_GROUP
C_STATE = 64
MIX_WIDTH = A_WIDTH + B_WIDTH + C_WIDTH
CHUNK = 64
NORM_EPS = 1e-6
IN_SIZES = (A_WIDTH, A_WIDTH, A_WIDTH, A_WIDTH, B_QK, B_QK, B_WIDTH, B_WIDTH, GLA_RANK, C_WIDTH, C_WIDTH)
IN_TOTAL = sum(IN_SIZES)

kernel_name = 'hymba_style_hgrn2_gla_s5_step'


def _split_points():
    pts, acc = [], 0
    for s in IN_SIZES[:-1]:
        acc += s
        pts.append(acc)
    return pts


def rmsnorm(x, g):
    xf = x.astype(jnp.float32)
    r = lax.rsqrt(jnp.mean(xf * xf, axis=-1, keepdims=True) + NORM_EPS)
    return (xf * r * g.astype(jnp.float32)).astype(x.dtype)


def head_rmsnorm(o, g):
    r = lax.rsqrt(jnp.mean(o * o, axis=-1, keepdims=True) + NORM_EPS)
    return o * r * g.astype(jnp.float32).reshape(o.shape[2], o.shape[3])


def gated_recurrence(q, k, v, log_a, s0):
    bsz, t, h, dk = q.shape
    c = min(CHUNK, t)
    n = -(-t // c)
    pad = n * c - t
    if pad:
        pw = ((0, 0), (0, pad), (0, 0), (0, 0))
        q, k, v, log_a = (jnp.pad(q, pw), jnp.pad(k, pw), jnp.pad(v, pw), jnp.pad(log_a, pw))

    def to_chunks(a):
        return a.reshape(bsz, n, c, h, a.shape[-1]).swapaxes(0, 1)

    causal = jnp.tril(jnp.ones((c, c), dtype=bool))

    def step(S, inp):
        qc, kc, vc, gc = inp
        b = jnp.cumsum(gc, axis=1)
        o_inter = jnp.einsum('bthk,bhkv->bthv', qc * jnp.exp(b), S)
        diff = b[:, :, None] - b[:, None]
        decay = jnp.exp(jnp.where(causal[None, :, :, None, None], diff, -jnp.inf))
        att = jnp.einsum('bthk,bshk,btshk->bths', qc, kc, decay)
        o_intra = jnp.einsum('bths,bshv->bthv', att, vc)
        b_last = b[:, -1]
        S_new = jnp.exp(b_last)[..., None] * S + jnp.einsum(
            'bshk,bshv->bhkv', kc * jnp.exp(b_last[:, None] - b), vc)
        return S_new, o_inter + o_intra

    s_fin, o = lax.scan(step, s0, (to_chunks(q), to_chunks(k), to_chunks(v), to_chunks(log_a)))
    o = o.swapaxes(0, 1).reshape(bsz, n * c, h, v.shape[-1])[:, :t]
    return o, s_fin


def _complex_affine_combine(e1, e2):
    a1r, a1i, b1r, b1i = e1
    a2r, a2i, b2r, b2i = e2
    ar = a2r * a1r - a2i * a1i
    ai = a2r * a1i + a2i * a1r
    br = a2r * b1r - a2i * b1i + b2r
    bi = a2r * b1i + a2i * b1r + b2i
    return ar, ai, br, bi


def s5_ssm(u, A_re, A_im, B_re, B_im, C_re, C_im, D, log_dt, x0_re, x0_im):
    f32 = jnp.float32
    dt = jnp.exp(log_dt.astype(f32))[:, None]
    lr, li = A_re.astype(f32), A_im.astype(f32)
    mag = jnp.exp(lr * dt)
    ab_re = mag * jnp.cos(li * dt)
    ab_im = mag * jnp.sin(li * dt)
    den = lr * lr + li * li
    nr = ab_re - 1.0
    co_re = (nr * lr + ab_im * li) / den
    co_im = (ab_im * lr - nr * li) / den
    Br, Bi = B_re.astype(f32), B_im.astype(f32)
    bb_re = co_re[..., None] * Br - co_im[..., None] * Bi
    bb_im = co_re[..., None] * Bi + co_im[..., None] * Br
    bu_re = jnp.einsum('gpc,btgc->btgp', bb_re, u)
    bu_im = jnp.einsum('gpc,btgc->btgp', bb_im, u)
    a_re = jnp.broadcast_to(ab_re, bu_re.shape)
    a_im = jnp.broadcast_to(ab_im, bu_re.shape)
    ac_re, ac_im, h_re, h_im = lax.associative_scan(
        _complex_affine_combine, (a_re, a_im, bu_re, bu_im), axis=1)
    x_re = h_re + ac_re * x0_re[:, None] - ac_im * x0_im[:, None]
    x_im = h_im + ac_re * x0_im[:, None] + ac_im * x0_re[:, None]
    y = (jnp.einsum('gcp,btgp->btgc', C_re.astype(f32), x_re)
         - jnp.einsum('gcp,btgp->btgc', C_im.astype(f32), x_im)
         + D.astype(f32).reshape(C_GROUPS, C_GROUP) * u)
    return y, x_re[:, -1], x_im[:, -1]


def mixer_layer(x, s_hg, s_gla, s_re, s_im, lb, norm_g, w_in, hg_norm_g, gla_w2, gla_b2,
                gla_norm_g, A_re, A_im, B_re, B_im, C_re, C_im, D, log_dt, w_glu, b_glu, w_out):
    f32 = jnp.float32
    bsz, t, _ = x.shape
    h = rmsnorm(x, norm_g)
    p = jnp.einsum('btd,de->bte', h, w_in).astype(f32)
    qa, fa, ia, za, qb, kb, vb, zb, rb, uc, zc = jnp.split(p, _split_points(), axis=-1)

    lbf = lb.astype(f32)
    log_f = jnp.logaddexp(jnp.log(lbf), jnp.log1p(-lbf) + jax.nn.log_sigmoid(fa))
    k_a = (1.0 - lbf) * jax.nn.sigmoid(-fa)
    q_a = jax.nn.silu(qa)
    shp_a = (bsz, t, A_HEADS, A_DK)
    o_a, s_hg_new = gated_recurrence(q_a.reshape(shp_a), k_a.reshape(shp_a),
                                     ia.reshape(bsz, t, A_HEADS, A_DV), log_f.reshape(shp_a),
                                     s_hg.astype(f32))
    o_a = head_rmsnorm(o_a, hg_norm_g).reshape(bsz, t, A_WIDTH) * jax.nn.silu(za)

    log_g = jax.nn.log_sigmoid(rb @ gla_w2.astype(f32) + gla_b2.astype(f32)) / GLA_TAU
    shp_b = (bsz, t, B_HEADS, B_DK)
    o_b, s_gla_new = gated_recurrence((qb * B_DK ** -0.5).reshape(shp_b), kb.reshape(shp_b),
                                      vb.reshape(bsz, t, B_HEADS, B_DV), log_g.reshape(shp_b),
                                      s_gla.astype(f32))
    o_b = head_rmsnorm(o_b, gla_norm_g).reshape(bsz, t, B_WIDTH) * jax.nn.silu(zb)

    y_c, s_re_new, s_im_new = s5_ssm(uc.reshape(bsz, t, C_GROUPS, C_GROUP), A_re, A_im, B_re, B_im,
                                     C_re, C_im, D, log_dt, s_re.astype(f32), s_im.astype(f32))
    y_c = jax.nn.gelu(y_c.reshape(bsz, t, C_WIDTH))
    y_c = y_c * jax.nn.sigmoid(y_c @ w_glu.astype(f32) + b_glu.astype(f32))
    o_c = y_c * jax.nn.silu(zc)

    mix = jnp.concatenate([o_a, o_b, o_c], axis=-1).astype(x.dtype)
    out = jnp.einsum('bte,ed->btd', mix, w_out)
    return x + out.astype(x.dtype), s_hg_new, s_gla_new, s_re_new, s_im_new


def setup_inputs(seed: int = 0) -> dict:
    key = jax.random.key(seed)
    ks = jax.random.split(key, 32)
    f32 = jnp.float32

    def nrm(k, shape, scale):
        return jax.random.normal(k, shape, f32) * scale

    log_dt = jax.random.uniform(ks[20], (DEPTH, C_GROUPS), f32,
                                minval=math.log(1e-3), maxval=math.log(1e-1))
    a_im = math.pi * jnp.arange(C_STATE, dtype=f32)
    return {
        'x_prompt': nrm(ks[0], (BATCH, SEQ, D_MODEL), 1.0),
        'x_sample': nrm(ks[1], (DEC_BATCH, DEC_SEQ, D_MODEL), 1.0),
        'state_hgrn': nrm(ks[2], (DEPTH, DEC_BATCH, A_HEADS, A_DK, A_DV), 0.5),
        'state_gla': nrm(ks[3], (DEPTH, DEC_BATCH, B_HEADS, B_DK, B_DV), 1.0),
        'state_s5_re': nrm(ks[4], (DEPTH, DEC_BATCH, C_GROUPS, C_STATE), 0.5),
        'state_s5_im': nrm(ks[5], (DEPTH, DEC_BATCH, C_GROUPS, C_STATE), 0.5),
        'norm_g': 1.0 + nrm(ks[6], (DEPTH, D_MODEL), 0.02),
        'w_in': nrm(ks[7], (DEPTH, D_MODEL, IN_TOTAL), D_MODEL ** -0.5),
        'hg_lb_logits': nrm(ks[8], (DEPTH, A_WIDTH), 0.5),
        'hg_norm_g': 1.0 + nrm(ks[9], (DEPTH, A_WIDTH), 0.02),
        'gla_w2': nrm(ks[10], (DEPTH, GLA_RANK, B_QK), GLA_RANK ** -0.5),
        'gla_b2': nrm(ks[11], (DEPTH, B_QK), 0.01),
        'gla_norm_g': 1.0 + nrm(ks[12], (DEPTH, B_WIDTH), 0.02),
        's5_A_re': -0.5 + nrm(ks[13], (DEPTH, C_GROUPS, C_STATE), 0.01),
        's5_A_im': a_im + nrm(ks[14], (DEPTH, C_GROUPS, C_STATE), 0.01),
        's5_B_re': nrm(ks[15], (DEPTH, C_GROUPS, C_STATE, C_GROUP), (2 * C_GROUP) ** -0.5),
        's5_B_im': nrm(ks[16], (DEPTH, C_GROUPS, C_STATE, C_GROUP), (2 * C_GROUP) ** -0.5),
        's5_C_re': nrm(ks[17], (DEPTH, C_GROUPS, C_GROUP, C_STATE), C_STATE ** -0.5),
        's5_C_im': nrm(ks[18], (DEPTH, C_GROUPS, C_GROUP, C_STATE), C_STATE ** -0.5),
        's5_D': nrm(ks[19], (DEPTH, C_WIDTH), 1.0),
        's5_log_dt': log_dt,
        's5_w_glu': nrm(ks[21], (DEPTH, C_WIDTH, C_WIDTH), C_WIDTH ** -0.5),
        's5_b_glu': nrm(ks[22], (DEPTH, C_WIDTH), 0.01),
        'w_out': nrm(ks[23], (DEPTH, MIX_WIDTH, D_MODEL), MIX_WIDTH ** -0.5),
        'final_norm_g': 1.0 + nrm(ks[24], (D_MODEL,), 0.02),
    }


def reference(x_prompt, x_sample, state_hgrn, state_gla, state_s5_re, state_s5_im, norm_g, w_in,
              hg_lb_logits, hg_norm_g, gla_w2, gla_b2, gla_norm_g, s5_A_re, s5_A_im, s5_B_re,
              s5_B_im, s5_C_re, s5_C_im, s5_D, s5_log_dt, s5_w_glu, s5_b_glu, w_out, final_norm_g):
    f32 = jnp.float32
    cum = jnp.cumsum(jax.nn.softmax(hg_lb_logits.astype(f32), axis=0), axis=0)
    lb_all = cum - cum[0:1]

    bp = x_prompt.shape[0]
    z_hg = jnp.zeros((bp, A_HEADS, A_DK, A_DV), f32)
    z_gla = jnp.zeros((bp, B_HEADS, B_DK, B_DV), f32)
    z_s5 = jnp.zeros((bp, C_GROUPS, C_STATE), f32)

    yp, ys = x_prompt, x_sample
    hg_p, gla_p, re_p, im_p = [], [], [], []
    hg_s, gla_s, re_s, im_s = [], [], [], []
    for l in range(DEPTH):
        w = (norm_g[l], w_in[l], hg_norm_g[l], gla_w2[l], gla_b2[l], gla_norm_g[l],
             s5_A_re[l], s5_A_im[l], s5_B_re[l], s5_B_im[l], s5_C_re[l], s5_C_im[l],
             s5_D[l], s5_log_dt[l], s5_w_glu[l], s5_b_glu[l], w_out[l])
        yp, a1, a2, a3, a4 = mixer_layer(yp, z_hg, z_gla, z_s5, z_s5, lb_all[l], *w)
        ys, b1, b2, b3, b4 = mixer_layer(ys, state_hgrn[l], state_gla[l], state_s5_re[l],
                                         state_s5_im[l], lb_all[l], *w)
        hg_p.append(a1); gla_p.append(a2); re_p.append(a3); im_p.append(a4)
        hg_s.append(b1); gla_s.append(b2); re_s.append(b3); im_s.append(b4)

    y_prompt = rmsnorm(yp, final_norm_g)
    y_sample = rmsnorm(ys, final_norm_g)
    hgrn_prompt = jnp.stack(hg_p, axis=0)
    gla_prompt = jnp.stack(gla_p, axis=0)
    s5re_prompt = jnp.stack(re_p, axis=0)
    s5im_prompt = jnp.stack(im_p, axis=0)
    hgrn_sample = jnp.stack(hg_s, axis=0)
    gla_sample = jnp.stack(gla_s, axis=0)
    s5re_sample = jnp.stack(re_s, axis=0)
    s5im_sample = jnp.stack(im_s, axis=0)
    return (y_prompt, y_sample, hgrn_prompt, gla_prompt, s5re_prompt, s5im_prompt,
            hgrn_sample, gla_sample, s5re_sample, s5im_sample)
```

```cpp
#include <hip/hip_runtime.h>
#include <hip/hip_cooperative_groups.h>
#include <cstdio>
#include <cstdint>
namespace cg = cooperative_groups;

#ifndef MEGA
#define MEGA 1
#endif

typedef unsigned short bf16_t;
typedef short bf16x8 __attribute__((ext_vector_type(8)));
typedef float f32x4 __attribute__((ext_vector_type(4)));
typedef unsigned u32x4 __attribute__((ext_vector_type(4)));
typedef unsigned u32x2 __attribute__((ext_vector_type(2)));
#define DEV __device__ __forceinline__

constexpr int D = 1024, TP = 16384, TS = 128, MT = 16512, MPAD = 16640, NIN = 3216, NPERM = 3584;
constexpr float EPS = 1e-6f;
constexpr int NTHR = 512;
constexpr int LDS_BYTES = 144 * 1024;
constexpr int NPHASE = 14;

constexpr size_t al(size_t x) { return (x + 255) & ~size_t(255); }
constexpr size_t O_BTIN = 0;
constexpr size_t O_BTOUT = O_BTIN + al(2ull * NPERM * 1024 * 2);
constexpr size_t O_BTGLU = O_BTOUT + al(2ull * 1024 * 1024 * 2);
constexpr size_t O_BTS5Y = O_BTGLU + al(2ull * 256 * 256 * 2);
constexpr size_t O_BTS5S = O_BTS5Y + al(2ull * 16 * 256 * 384 * 2);
constexpr size_t O_A16 = O_BTS5S + al(2ull * 16 * 128 * 256 * 2);
constexpr size_t O_ABAR = O_A16 + al(2ull * 16 * 64 * 2 * 4);
constexpr size_t O_BB = O_ABAR + al(2ull * 16 * 64 * 2 * 4);
constexpr size_t O_LB = O_BB + al(2ull * 16 * 64 * 16 * 2 * 4);
constexpr size_t O_AX = O_LB + al(2ull * 384 * 4);
constexpr size_t O_RSQ = O_AX + al((size_t)MPAD * 1024 * 2);
constexpr size_t O_HQ = O_RSQ + al((size_t)MPAD * 16 * 4);
constexpr size_t O_HV = O_HQ + al((size_t)MPAD * 384 * 2);
constexpr size_t O_HZ = O_HV + al((size_t)MPAD * 384 * 2);
constexpr size_t O_HG = O_HZ + al((size_t)MPAD * 384 * 2);
constexpr size_t O_GQ = O_HG + al((size_t)MPAD * 384 * 4);
constexpr size_t O_GV = O_GQ + al((size_t)MPAD * 384 * 2);
constexpr size_t O_GZ = O_GV + al((size_t)MPAD * 384 * 2);
constexpr size_t O_GR = O_GZ + al((size_t)MPAD * 384 * 2);
constexpr size_t O_AS5 = O_GR + al((size_t)MPAD * 16 * 4);
constexpr size_t O_SUS = O_AS5 + al(16ull * 1024 * 384 * 2);
constexpr size_t O_SZ = O_SUS + al(128ull * 256 * 4);
constexpr size_t O_MIX = O_SZ + al((size_t)MPAD * 256 * 2);
constexpr size_t O_DSH = O_MIX + al((size_t)MPAD * 1024 * 2);
constexpr size_t O_DDH = O_DSH + al(1536ull * 4096 * 2);
constexpr size_t O_DSG = O_DDH + al(1536ull * 64 * 4);
constexpr size_t O_DDG = O_DSG + al(1536ull * 2048 * 2);
constexpr size_t O_S5S = O_DDG + al(1536ull * 32 * 4);
constexpr size_t O_END = O_S5S + al(16ull * 1024 * 128 * 4);

constexpr size_t OUT_YS = 16777216, OUT_HP = 16908288, OUT_GP = 17301504, OUT_RP = 17498112, OUT_IP = 17514496,
                 OUT_HS = 17530880, OUT_GS = 23822336, OUT_RS = 26968064, OUT_IS = 27230208;

struct P {
    const float* in[25];
    float* out;
    unsigned char* ws;
    int ph_lo, ph_hi;
};

struct Ctx { int tid, bid, G; };

typedef __bf16 bf16x2_t __attribute__((ext_vector_type(2)));
typedef float f32x2_t __attribute__((ext_vector_type(2)));
DEV unsigned cvt_pk(float lo, float hi) { const f32x2_t f = {lo, hi}; const bf16x2_t b = __builtin_convertvector(f, bf16x2_t); return __builtin_bit_cast(unsigned, b); }
DEV bf16_t f2bf(float f) { return (bf16_t)(cvt_pk(f, 0.f) & 0xffffu); }
DEV float bf2f(bf16_t b) { return __uint_as_float(((unsigned)b) << 16); }
DEV float bflo(unsigned w) { return __uint_as_float(w << 16); }
DEV float bfhi(unsigned w) { return __uint_as_float(w & 0xffff0000u); }
DEV float wave_sum(float v) {
#pragma unroll
    for (int o = 32; o >= 1; o >>= 1) v += __shfl_xor(v, o);
    return v;
}
DEV float sigmoidf_(float x) { return 1.0f / (1.0f + __expf(-x)); }
DEV float siluf_(float x) { return x * sigmoidf_(x); }
DEV float logsigf_(float x) { return fminf(x, 0.f) - log1pf(__expf(-fabsf(x))); }
DEV float geluf_(float x) { const float u = 0.7978845608028654f * (x + 0.044715f * x * x * x); const float t = 1.0f - 2.0f / (1.0f + __expf(2.0f * u)); return 0.5f * x * (1.0f + t); }
DEV float expc(float x) { return __expf(fminf(x, 80.f)); }

DEV int perm_src(int np) {
    const int pn = np >> 8, j = np & 255;
    if (pn < 6) return (j >> 6) * 384 + pn * 64 + (j & 63);
    if (pn < 12) {
        const int h = pn - 6;
        if (j < 32) return 1536 + h * 32 + j;
        if (j < 64) return 1728 + h * 32 + (j - 32);
        if (j < 128) return 1920 + h * 64 + (j - 64);
        if (j < 192) return 2304 + h * 64 + (j - 128);
        if (j < 208 && h == 0) return 2688 + (j - 192);
        return -1;
    }
    if (pn == 12) return 2704 + j;
    return 2960 + j;
}

DEV void cis_d(double th, double& c, double& s) {
    const double n = rint(th * 0.15915494309189535);
    double r = fma(-n, 6.283185307179586, th); r = fma(-n, 2.4492935982947064e-16, r);
    const double x = r * (1.0 / 64.0), x2 = x * x;
    double sn = x * (1.0 - x2 * (1.0 / 6.0) * (1.0 - x2 * (1.0 / 20.0) * (1.0 - x2 * (1.0 / 42.0) * (1.0 - x2 * (1.0 / 72.0)))));
    double cs = 1.0 - x2 * 0.5 * (1.0 - x2 * (1.0 / 12.0) * (1.0 - x2 * (1.0 / 30.0) * (1.0 - x2 * (1.0 / 56.0) * (1.0 - x2 * (1.0 / 90.0)))));
#pragma unroll
    for (int i = 0; i < 6; ++i) { const double c2 = cs * cs - sn * sn, s2 = 2.0 * cs * sn; cs = c2; sn = s2; }
    c = cs; s = sn;
}

DEV void gemm128(const Ctx cx, const bf16_t* __restrict__ A, int lda, const bf16_t* __restrict__ Bt, int ldb, int K, int row0, int col0,
                 unsigned char* lds, f32x4 (&acc)[2][4]) {
    const int tid = cx.tid, lane = tid & 63, wid = tid >> 6, wr = wid >> 1, wc = wid & 1, fr = lane & 15, fq = lane >> 4;
    bf16_t* sA = (bf16_t*)lds;
    bf16_t* sB = sA + 128 * 72;
    const int r0 = tid >> 3, c0 = (tid & 7) * 8;
    const bf16_t* pa = A + (size_t)(row0 + r0) * lda + c0;
    const bf16_t* pb = Bt + (size_t)(col0 + r0) * ldb + c0;
    const size_t sa64 = (size_t)64 * lda, sb64 = (size_t)64 * ldb;
#pragma unroll
    for (int mi = 0; mi < 2; ++mi)
#pragma unroll
        for (int ni = 0; ni < 4; ++ni) acc[mi][ni] = (f32x4){0.f, 0.f, 0.f, 0.f};
    u32x4 ra0 = *(const u32x4*)pa, ra1 = *(const u32x4*)(pa + sa64), rb0 = *(const u32x4*)pb, rb1 = *(const u32x4*)(pb + sb64);
    for (int k0 = 0; k0 < K; k0 += 64) {
        __syncthreads();
        *(u32x4*)(sA + r0 * 72 + c0) = ra0; *(u32x4*)(sA + (r0 + 64) * 72 + c0) = ra1;
        *(u32x4*)(sB + r0 * 72 + c0) = rb0; *(u32x4*)(sB + (r0 + 64) * 72 + c0) = rb1;
        __syncthreads();
        if (k0 + 64 < K) {
            ra0 = *(const u32x4*)(pa + k0 + 64); ra1 = *(const u32x4*)(pa + sa64 + k0 + 64);
            rb0 = *(const u32x4*)(pb + k0 + 64); rb1 = *(const u32x4*)(pb + sb64 + k0 + 64);
        }
#pragma unroll
        for (int kk = 0; kk < 2; ++kk) {
            bf16x8 af[2], bfr[4];
#pragma unroll
            for (int mi = 0; mi < 2; ++mi) af[mi] = *(const bf16x8*)(sA + (wr * 32 + mi * 16 + fr) * 72 + kk * 32 + fq * 8);
#pragma unroll
            for (int ni = 0; ni < 4; ++ni) bfr[ni] = *(const bf16x8*)(sB + (wc * 64 + ni * 16 + fr) * 72 + kk * 32 + fq * 8);
#pragma unroll
            for (int mi = 0; mi < 2; ++mi)
#pragma unroll
                for (int ni = 0; ni < 4; ++ni) acc[mi][ni] = __builtin_amdgcn_mfma_f32_16x16x32_bf16(bfr[ni], af[mi], acc[mi][ni], 0, 0, 0);
        }
    }
}

DEV void s5_precompute(const Ctx cx, const P& p, int it, unsigned char* lds) {
    const int tid = cx.tid;
    const int l = it >> 4, g = it & 15, lg = it;
    float* Ap = (float*)lds;
    float* Bbs = Ap + 17 * 64 * 2;
    float* Cs = Bbs + 64 * 16 * 2;
    float* Km = Cs + 16 * 64 * 2;
    unsigned char* ws = p.ws;
    __syncthreads();
    const float dt = expf(p.in[20][lg]);
    for (int e = tid; e < 17 * 64; e += NTHR) {
        const int j = e >> 6, pp = e & 63;
        const float lr = p.in[13][lg * 64 + pp], li = p.in[14][lg * 64 + pp];
        const float mag = expf((float)j * lr * dt);
        double c, s; cis_d((double)li * (double)dt * (double)j, c, s);
        Ap[e * 2] = mag * (float)c; Ap[e * 2 + 1] = mag * (float)s;
    }
    __syncthreads();
    float* BBg = (float*)(ws + O_BB);
    for (int e = tid; e < 64 * 16; e += NTHR) {
        const int pp = e >> 4, cc = e & 15;
        const float lr = p.in[13][lg * 64 + pp], li = p.in[14][lg * 64 + pp];
        const float abr = Ap[(64 + pp) * 2], abi = Ap[(64 + pp) * 2 + 1], nr = abr - 1.0f, den = lr * lr + li * li;
        const float cor = (nr * lr + abi * li) / den, coi = (abi * lr - nr * li) / den;
        const float Br = p.in[15][(lg * 64 + pp) * 16 + cc], Bi = p.in[16][(lg * 64 + pp) * 16 + cc];
        const float bbr = cor * Br - coi * Bi, bbi = cor * Bi + coi * Br;
        Bbs[e * 2] = bbr; Bbs[e * 2 + 1] = bbi;
        BBg[((size_t)(lg * 64 + pp) * 16 + cc) * 2] = bbr; BBg[((size_t)(lg * 64 + pp) * 16 + cc) * 2 + 1] = bbi;
    }
    for (int e = tid; e < 16 * 64; e += NTHR) {
        const int cc = e >> 6, pp = e & 63;
        Cs[e * 2] = p.in[17][(lg * 16 + cc) * 64 + pp]; Cs[e * 2 + 1] = p.in[18][(lg * 16 + cc) * 64 + pp];
    }
    if (tid < 64) {
        float* A16 = (float*)(ws + O_A16); float* AB = (float*)(ws + O_ABAR);
        A16[(lg * 64 + tid) * 2] = Ap[(16 * 64 + tid) * 2]; A16[(lg * 64 + tid) * 2 + 1] = Ap[(16 * 64 + tid) * 2 + 1];
        AB[(lg * 64 + tid) * 2] = Ap[(64 + tid) * 2]; AB[(lg * 64 + tid) * 2 + 1] = Ap[(64 + tid) * 2 + 1];
    }
    __syncthreads();
    for (int e = tid; e < 4096; e += NTHR) {
        const int j = e >> 8, c = (e >> 4) & 15, c2 = e & 15;
        float acc = 0.f;
        for (int pp = 0; pp < 64; ++pp) {
            const float cr = Cs[(c * 64 + pp) * 2], ci = Cs[(c * 64 + pp) * 2 + 1], ar = Ap[(j * 64 + pp) * 2], ai = Ap[(j * 64 + pp) * 2 + 1];
            const float br = Bbs[(pp * 16 + c2) * 2], bi = Bbs[(pp * 16 + c2) * 2 + 1];
            const float car = cr * ar - ci * ai, cai = cr * ai + ci * ar;
            acc += car * br - cai * bi;
        }
        if (j == 0 && c == c2) acc += p.in[19][l * 256 + g * 16 + c];
        Km[e] = acc;
    }
    __syncthreads();
    bf16_t* Y = (bf16_t*)(ws + O_BTS5Y) + (size_t)lg * 256 * 384;
    for (int e = tid; e < 256 * 384; e += NTHR) {
        const int n = e / 384, k = e - n * 384, i = n >> 4, c = n & 15;
        float v;
        if (k < 256) { const int j = k >> 4, c2 = k & 15; v = (j <= i) ? Km[((i - j) * 16 + c) * 16 + c2] : 0.f; }
        else { const int pp = (k - 256) & 63, imf = (k - 256) >> 6;
            const float cr = Cs[(c * 64 + pp) * 2], ci = Cs[(c * 64 + pp) * 2 + 1], ar = Ap[((i + 1) * 64 + pp) * 2], ai = Ap[((i + 1) * 64 + pp) * 2 + 1];
            v = imf ? -(cr * ai + ci * ar) : (cr * ar - ci * ai); }
        Y[e] = f2bf(v);
    }
    bf16_t* S = (bf16_t*)(ws + O_BTS5S) + (size_t)lg * 128 * 256;
    for (int e = tid; e < 128 * 256; e += NTHR) {
        const int n = e >> 8, k = e & 255, pp = n & 63, imf = n >> 6, j = k >> 4, c2 = k & 15;
        const float ar = Ap[((15 - j) * 64 + pp) * 2], ai = Ap[((15 - j) * 64 + pp) * 2 + 1], br = Bbs[(pp * 16 + c2) * 2], bi = Bbs[(pp * 16 + c2) * 2 + 1];
        S[e] = f2bf(imf ? (ar * bi + ai * br) : (ar * br - ai * bi));
    }
}

DEV void phase_prep(const Ctx cx, const P& p, unsigned char* lds) {
    const int tid = cx.tid, lane = tid & 63, wid = tid >> 6, G = cx.G, bid = cx.bid;
    unsigned char* ws = p.ws;
    for (int it = bid; it < 32; it += G) s5_precompute(cx, p, it, lds);
    {
        bf16_t* AX = (bf16_t*)(ws + O_AX); float* RSQ = (float*)(ws + O_RSQ);
        for (int row = bid * 8 + wid; row < MPAD; row += G * 8) {
            const float* src = row < TP ? p.in[0] + (size_t)row * D : (row < MT ? p.in[1] + (size_t)(row - TP) * D : nullptr);
            float ss = 0.f;
#pragma unroll
            for (int i = 0; i < 4; ++i) {
                const int col = i * 256 + lane * 4;
                f32x4 v = (f32x4){0.f, 0.f, 0.f, 0.f};
                if (src) v = *(const f32x4*)(src + col);
                ss += v[0] * v[0] + v[1] * v[1] + v[2] * v[2] + v[3] * v[3];
                u32x2 w; w.x = cvt_pk(v[0], v[1]); w.y = cvt_pk(v[2], v[3]);
                *(u32x2*)(AX + (size_t)row * D + col) = w;
            }
            ss = wave_sum(ss);
            if (lane < 16) RSQ[row * 16 + lane] = (lane == 0) ? ss : 0.f;
        }
    }
    const int gt = bid * NTHR + tid, GT = G * NTHR;
    for (int idx = gt; idx < 2 * NPERM * 128; idx += GT) {
        const int np = idx % NPERM, k8 = ((idx / NPERM) & 127) * 8, l = idx / (NPERM * 128);
        const int n = perm_src(np);
        u32x4 w = (u32x4){0u, 0u, 0u, 0u};
        if (n >= 0) {
            const float* W = p.in[7] + (size_t)l * D * NIN + n; const float* g = p.in[6] + l * D + k8;
            float v[8];
#pragma unroll
            for (int e = 0; e < 8; ++e) v[e] = W[(size_t)(k8 + e) * NIN] * g[e];
            w.x = cvt_pk(v[0], v[1]); w.y = cvt_pk(v[2], v[3]); w.z = cvt_pk(v[4], v[5]); w.w = cvt_pk(v[6], v[7]);
        }
        *(u32x4*)((bf16_t*)(ws + O_BTIN) + ((size_t)l * NPERM + np) * D + k8) = w;
    }
    for (int idx = gt; idx < 2 * 1024 * 128; idx += GT) {
        const int d = idx & 1023, e8 = ((idx >> 10) & 127) * 8, l = idx >> 17;
        const float* W = p.in[23] + (size_t)l * D * D + d;
        float v[8];
#pragma unroll
        for (int e = 0; e < 8; ++e) v[e] = W[(size_t)(e8 + e) * D];
        u32x4 w; w.x = cvt_pk(v[0], v[1]); w.y = cvt_pk(v[2], v[3]); w.z = cvt_pk(v[4], v[5]); w.w = cvt_pk(v[6], v[7]);
        *(u32x4*)((bf16_t*)(ws + O_BTOUT) + ((size_t)l * D + d) * D + e8) = w;
    }
    for (int idx = gt; idx < 2 * 256 * 32; idx += GT) {
        const int n = idx & 255, i8 = ((idx >> 8) & 31) * 8, l = idx >> 13;
        const float* W = p.in[21] + (size_t)l * 65536 + n;
        float v[8];
#pragma unroll
        for (int e = 0; e < 8; ++e) v[e] = W[(size_t)(i8 + e) * 256];
        u32x4 w; w.x = cvt_pk(v[0], v[1]); w.y = cvt_pk(v[2], v[3]); w.z = cvt_pk(v[4], v[5]); w.w = cvt_pk(v[6], v[7]);
        *(u32x4*)((bf16_t*)(ws + O_BTGLU) + ((size_t)l * 256 + n) * 256 + i8) = w;
    }
    for (int idx = gt; idx < 384; idx += GT) {
        const float l0 = p.in[8][idx], l1 = p.in[8][384 + idx], m = fmaxf(l0, l1), e0 = expf(l0 - m), e1 = expf(l1 - m);
        float* LB = (float*)(ws + O_LB);
        LB[idx] = 0.f; LB[384 + idx] = e1 / (e0 + e1);
    }
}

DEV void st4bf(bf16_t* dst, f32x4 v) { u32x2 w; w.x = cvt_pk(v[0], v[1]); w.y = cvt_pk(v[2], v[3]); *(u32x2*)dst = w; }

DEV void inproj_store(const P& p, int l, int row, int ncol, f32x4 v) {
    unsigned char* ws = p.ws;
    const int pn = ncol >> 8, j = ncol & 255;
    if (pn < 6) {
        const int seg = j >> 6, c = pn * 64 + (j & 63);
        if (seg == 0) { st4bf((bf16_t*)(ws + O_HQ) + (size_t)row * 384 + c, (f32x4){siluf_(v[0]), siluf_(v[1]), siluf_(v[2]), siluf_(v[3])}); }
        else if (seg == 1) {
            const f32x4 lb = *(const f32x4*)((const float*)(ws + O_LB) + l * 384 + c);
            f32x4 o;
#pragma unroll
            for (int r = 0; r < 4; ++r) o[r] = logf(lb[r] + (1.0f - lb[r]) * sigmoidf_(v[r]));
            *(f32x4*)((float*)(ws + O_HG) + (size_t)row * 384 + c) = o;
        }
        else if (seg == 2) st4bf((bf16_t*)(ws + O_HV) + (size_t)row * 384 + c, v);
        else st4bf((bf16_t*)(ws + O_HZ) + (size_t)row * 384 + c, (f32x4){siluf_(v[0]), siluf_(v[1]), siluf_(v[2]), siluf_(v[3])});
    } else if (pn < 12) {
        const int h = pn - 6;
        if (j < 32) st4bf((bf16_t*)(ws + O_GQ) + (size_t)row * 384 + h * 64 + j, v * 0.17677669529663687f);
        else if (j < 64) st4bf((bf16_t*)(ws + O_GQ) + (size_t)row * 384 + h * 64 + j, v);
        else if (j < 128) st4bf((bf16_t*)(ws + O_GV) + (size_t)row * 384 + h * 64 + (j - 64), v);
        else if (j < 192) st4bf((bf16_t*)(ws + O_GZ) + (size_t)row * 384 + h * 64 + (j - 128), (f32x4){siluf_(v[0]), siluf_(v[1]), siluf_(v[2]), siluf_(v[3])});
        else if (j < 208 && h == 0) *(f32x4*)((float*)(ws + O_GR) + (size_t)row * 16 + (j - 192)) = v;
    } else if (pn == 12) {
        if (row < TP) st4bf((bf16_t*)(ws + O_AS5) + ((size_t)(j >> 4) * 1024 + (row >> 4)) * 384 + (row & 15) * 16 + (j & 15), v);
        else if (row < MT) *(f32x4*)((float*)(ws + O_SUS) + (size_t)(row - TP) * 256 + j) = v;
    } else {
        st4bf((bf16_t*)(ws + O_SZ) + (size_t)row * 256 + j, (f32x4){siluf_(v[0]), siluf_(v[1]), siluf_(v[2]), siluf_(v[3])});
    }
}

DEV void phase_inproj(const Ctx cx, const P& p, int l, unsigned char* lds) {
    const int tid = cx.tid, lane = tid & 63, wid = tid >> 6, wr = wid >> 1, wc = wid & 1, fr = lane & 15, fq = lane >> 4;
    const bf16_t* AX = (const bf16_t*)(p.ws + O_AX);
    const bf16_t* Bt = (const bf16_t*)(p.ws + O_BTIN) + (size_t)l * NPERM * D;
    const float* RSQ = (const float*)(p.ws + O_RSQ);
    constexpr int NRT = MPAD / 128, NCT = NPERM / 128;
    for (int it = cx.bid; it < NRT * NCT; it += cx.G) {
        const int rt = it / NCT, ct = it - rt * NCT;
        f32x4 acc[2][4];
        gemm128(cx, AX, D, Bt, D, D, rt * 128, ct * 128, lds, acc);
#pragma unroll
        for (int mi = 0; mi < 2; ++mi) {
            const int row = rt * 128 + wr * 32 + mi * 16 + fr;
            float ss = 0.f;
#pragma unroll
            for (int i = 0; i < 4; ++i) { const f32x4 q = *(const f32x4*)(RSQ + row * 16 + i * 4); ss += q[0] + q[1] + q[2] + q[3]; }
            const float r = rsqrtf(ss * (1.0f / 1024.0f) + EPS);
#pragma unroll
            for (int ni = 0; ni < 4; ++ni) inproj_store(p, l, row, ct * 128 + wc * 64 + ni * 16 + 4 * fq, acc[mi][ni] * r);
        }
    }
}

template <int DK, int MODE>
DEV void chunk_item(const Ctx cx, const P& p, int l, int item, unsigned char* lds) {
    constexpr bool GLA = (DK == 32);
    constexpr int BSTR = DK + 4, KS = DK + 8, SS = 72, EPT = DK / 8;
    float* Bs = (float*)lds; float* Tot = Bs + 65 * BSTR; float* Rb = Tot + 16 * DK; float* W2s = Rb + 1024; float* b2s = W2s + 512; float* Psq = b2s + 32;
    bf16_t* Qh = (bf16_t*)(Psq + 128); bf16_t* Qt = Qh + 64 * KS; bf16_t* Kt = Qt + 64 * KS; bf16_t* ST = Kt + 4 * 64 * KS;
    bf16_t* VT = ST + 64 * KS; bf16_t* Att = VT + 64 * SS; bf16_t* KhT = Att + 64 * SS;
    const int tid = cx.tid, lane = tid & 63, wid = tid >> 6, fr = lane & 15, fq = lane >> 4;
    const int bh = item >> 5, c = item & 31, b = bh / 6, h = bh - b * 6, tok0 = b * 2048 + c * 64;
    unsigned char* ws = p.ws;
    bf16_t* DS = (bf16_t*)(ws + (GLA ? O_DSG : O_DSH)) + (size_t)item * 64 * DK;
    __syncthreads();
    if (!GLA) {
        const int t = tid >> 3, k8 = (tid & 7) * 8;
        const float* g = (const float*)(ws + O_HG) + (size_t)(tok0 + t) * 384 + h * 64 + k8;
        *(f32x4*)(Bs + (t + 1) * BSTR + k8) = *(const f32x4*)g; *(f32x4*)(Bs + (t + 1) * BSTR + k8 + 4) = *(const f32x4*)(g + 4);
    } else {
        if (tid < 256) { const int t = tid >> 2, r4 = (tid & 3) * 4; *(f32x4*)(Rb + t * 16 + r4) = *(const f32x4*)((const float*)(ws + O_GR) + (size_t)(tok0 + t) * 16 + r4); }
        { const int r = tid >> 5, k = tid & 31; W2s[tid] = p.in[10][(l * 16 + r) * 192 + h * 32 + k]; }
        if (tid < 32) b2s[tid] = p.in[11][l * 192 + h * 32 + tid];
        __syncthreads();
        const int t = tid >> 3, k4 = (tid & 7) * 4;
#pragma unroll
        for (int kk = 0; kk < 4; ++kk) {
            float a = b2s[k4 + kk];
#pragma unroll
            for (int r = 0; r < 16; ++r) a += Rb[t * 16 + r] * W2s[r * 32 + k4 + kk];
#ifdef DBG_GATE
            Bs[(t + 1) * BSTR + k4 + kk] = -0.05f + 0.f * a;
#else
            Bs[(t + 1) * BSTR + k4 + kk] = logsigf_(a) * (1.0f / 16.0f);
#endif
        }
    }
    if (tid < DK) Bs[tid] = 0.f;
    __syncthreads();
    {
        constexpr int NSEG = NTHR / DK, SEGLEN = 64 / NSEG;
        const int k = tid % DK, seg = tid / DK, t0 = seg * SEGLEN;
        float run = 0.f;
#pragma unroll
        for (int i = 0; i < SEGLEN; ++i) { run += Bs[(t0 + i + 1) * BSTR + k]; Bs[(t0 + i + 1) * BSTR + k] = run; }
        Tot[seg * DK + k] = run;
        __syncthreads();
        float off = 0.f;
        for (int s = 0; s < seg; ++s) off += Tot[s * DK + k];
#pragma unroll
        for (int i = 0; i < SEGLEN; ++i) Bs[(t0 + i + 1) * BSTR + k] += off;
    }
    __syncthreads();
    {
        const int t = tid >> 3, kp = tid & 7, k0 = kp * EPT, I = t >> 4; const size_t tok = (size_t)tok0 + t;
        float qv[EPT], kv[EPT], bt[EPT];
#pragma unroll
        for (int e = 0; e < EPT; ++e) bt[e] = Bs[(t + 1) * BSTR + k0 + e];
        if (!GLA) {
            const u32x4 qw = *(const u32x4*)((const bf16_t*)(ws + O_HQ) + tok * 384 + h * 64 + k0);
            qv[0] = bflo(qw.x); qv[1] = bfhi(qw.x); qv[2] = bflo(qw.y); qv[3] = bfhi(qw.y);
            if (EPT == 8) { qv[EPT - 4] = bflo(qw.z); qv[EPT - 3] = bfhi(qw.z); qv[EPT - 2] = bflo(qw.w); qv[EPT - 1] = bfhi(qw.w); }
#pragma unroll
            for (int e = 0; e < EPT; ++e) kv[e] = 1.0f - __expf(bt[e] - Bs[t * BSTR + k0 + e]);
        } else {
            const u32x2 qw = *(const u32x2*)((const bf16_t*)(ws + O_GQ) + tok * 384 + h * 64 + k0);
            const u32x2 kw = *(const u32x2*)((const bf16_t*)(ws + O_GQ) + tok * 384 + h * 64 + 32 + k0);
            qv[0] = bflo(qw.x); qv[1] = bfhi(qw.x); qv[2] = bflo(qw.y); qv[3] = bfhi(qw.y);
            kv[0] = bflo(kw.x); kv[1] = bfhi(kw.x); kv[2] = bflo(kw.y); kv[3] = bfhi(kw.y);
        }
        {
            const u32x4 vw = *(const u32x4*)((const bf16_t*)(ws + (GLA ? O_GV : O_HV)) + tok * 384 + h * 64 + kp * 8);
            const unsigned w4[4] = {vw.x, vw.y, vw.z, vw.w};
#pragma unroll
            for (int e = 0; e < 4; ++e) { VT[(kp * 8 + 2 * e) * SS + t] = (bf16_t)(w4[e] & 0xffffu); VT[(kp * 8 + 2 * e + 1) * SS + t] = (bf16_t)(w4[e] >> 16); }
        }
        if (MODE == 0) {
#pragma unroll
            for (int e = 0; e < EPT; ++e) KhT[(k0 + e) * SS + t] = f2bf(kv[e] * __expf(Bs[64 * BSTR + k0 + e] - bt[e]));
            if (tid < DK) ((float*)(ws + (GLA ? O_DDG : O_DDH)))[(size_t)item * DK + tid] = __expf(Bs[64 * BSTR + tid]);
        } else {
            float o1[EPT], o2[EPT];
#pragma unroll
            for (int e = 0; e < EPT; ++e) { o1[e] = qv[e] * __expf(bt[e]); o2[e] = qv[e] * __expf(bt[e] - Bs[(16 * I) * BSTR + k0 + e]); }
#pragma unroll
            for (int e = 0; e < EPT; e += 4) { st4bf(Qh + t * KS + k0 + e, (f32x4){o1[e], o1[e + 1], o1[e + 2], o1[e + 3]}); st4bf(Qt + t * KS + k0 + e, (f32x4){o2[e], o2[e + 1], o2[e + 2], o2[e + 3]}); }
            for (int I2 = I; I2 < 4; ++I2) {
#pragma unroll
                for (int e = 0; e < EPT; ++e) o1[e] = kv[e] * expc(Bs[(16 * I2) * BSTR + k0 + e] - bt[e]);
#pragma unroll
                for (int e = 0; e < EPT; e += 4) st4bf(Kt + (I2 * 64 + t) * KS + k0 + e, (f32x4){o1[e], o1[e + 1], o1[e + 2], o1[e + 3]});
            }
            if (EPT == 8) *(u32x4*)(ST + t * KS + k0) = *(const u32x4*)(DS + t * DK + k0);
            else *(u32x2*)(ST + t * KS + k0) = *(const u32x2*)(DS + t * DK + k0);
        }
    }
    __syncthreads();
    if (MODE == 0) {
        const int mi = wid & 3;
#pragma unroll
        for (int x = 0; x < DK / 32; ++x) {
            const int nj = (wid >> 2) * (DK / 32) + x;
            f32x4 acc = (f32x4){0.f, 0.f, 0.f, 0.f};
#pragma unroll
            for (int kk = 0; kk < 2; ++kk) {
                const bf16x8 a = *(const bf16x8*)(VT + (16 * mi + fr) * SS + kk * 32 + fq * 8);
                const bf16x8 bq = *(const bf16x8*)(KhT + (16 * nj + fr) * SS + kk * 32 + fq * 8);
                acc = __builtin_amdgcn_mfma_f32_16x16x32_bf16(bq, a, acc, 0, 0, 0);
            }
            st4bf(DS + (16 * mi + fr) * DK + 16 * nj + 4 * fq, acc);
        }
        return;
    }
#pragma unroll
    for (int rep = 0; rep < 2; ++rep) {
        const int idx = wid + rep * 8;
        if (idx < 10) {
            const int I = idx >= 6 ? 3 : (idx >= 3 ? 2 : (idx >= 1 ? 1 : 0)), J = idx - (I * (I + 1)) / 2;
            f32x4 acc = (f32x4){0.f, 0.f, 0.f, 0.f};
#pragma unroll
            for (int kk = 0; kk < DK / 32; ++kk) {
                const bf16x8 a = *(const bf16x8*)(Qt + (16 * I + fr) * KS + kk * 32 + fq * 8);
                const bf16x8 bq = *(const bf16x8*)(Kt + (I * 64 + 16 * J + fr) * KS + kk * 32 + fq * 8);
                acc = __builtin_amdgcn_mfma_f32_16x16x32_bf16(bq, a, acc, 0, 0, 0);
            }
            if (I == J) {
#pragma unroll
                for (int r = 0; r < 4; ++r) if (4 * fq + r > fr) acc[r] = 0.f;
            }
            st4bf(Att + (16 * I + fr) * SS + 16 * J + 4 * fq, acc);
        } else {
            const int z = idx - 10, I = z < 3 ? 0 : (z < 5 ? 1 : 2), J = z < 3 ? z + 1 : (z < 5 ? z - 1 : 3);
            *(u32x2*)(Att + (16 * I + fr) * SS + 16 * J + 4 * fq) = (u32x2){0u, 0u};
        }
    }
    __syncthreads();
    const int I = wid & 3, vh = wid >> 2;
    f32x4 o[2];
#pragma unroll
    for (int ni = 0; ni < 2; ++ni) {
        f32x4 acc = (f32x4){0.f, 0.f, 0.f, 0.f};
#pragma unroll
        for (int kk = 0; kk < DK / 32; ++kk) {
            const bf16x8 a = *(const bf16x8*)(Qh + (16 * I + fr) * KS + kk * 32 + fq * 8);
            const bf16x8 bq = *(const bf16x8*)(ST + (vh * 32 + ni * 16 + fr) * KS + kk * 32 + fq * 8);
            acc = __builtin_amdgcn_mfma_f32_16x16x32_bf16(bq, a, acc, 0, 0, 0);
        }
#pragma unroll
        for (int kk = 0; kk < 2; ++kk) {
            const bf16x8 a = *(const bf16x8*)(Att + (16 * I + fr) * SS + kk * 32 + fq * 8);
            const bf16x8 bq = *(const bf16x8*)(VT + (vh * 32 + ni * 16 + fr) * SS + kk * 32 + fq * 8);
            acc = __builtin_amdgcn_mfma_f32_16x16x32_bf16(bq, a, acc, 0, 0, 0);
        }
        o[ni] = acc;
    }
    float ss = 0.f;
#pragma unroll
    for (int ni = 0; ni < 2; ++ni) ss += o[ni][0] * o[ni][0] + o[ni][1] * o[ni][1] + o[ni][2] * o[ni][2] + o[ni][3] * o[ni][3];
    ss += __shfl_xor(ss, 16); ss += __shfl_xor(ss, 32);
    const int t = 16 * I + fr;
    if (fq == 0) Psq[t * 2 + vh] = ss;
    __syncthreads();
    const float sc = rsqrtf((Psq[t * 2] + Psq[t * 2 + 1]) * (1.0f / 64.0f) + EPS);
    const float* gain = p.in[GLA ? 12 : 9] + l * 384 + h * 64;
    const bf16_t* Z = (const bf16_t*)(ws + (GLA ? O_GZ : O_HZ)) + ((size_t)tok0 + t) * 384 + h * 64;
    bf16_t* MIX = (bf16_t*)(ws + O_MIX) + ((size_t)tok0 + t) * 1024 + (GLA ? 384 : 0) + h * 64;
#pragma unroll
    for (int ni = 0; ni < 2; ++ni) {
        const int v = vh * 32 + ni * 16 + 4 * fq;
        const f32x4 gn = *(const f32x4*)(gain + v);
        const u32x2 zw = *(const u32x2*)(Z + v);
        f32x4 r; r[0] = o[ni][0] * sc * gn[0] * bflo(zw.x); r[1] = o[ni][1] * sc * gn[1] * bfhi(zw.x); r[2] = o[ni][2] * sc * gn[2] * bflo(zw.y); r[3] = o[ni][3] * sc * gn[3] * bfhi(zw.y);
        st4bf(MIX + v, r);
    }
}

DEV void phase_b1(const Ctx cx, const P& p, int l, unsigned char* lds) {
    const int tid = cx.tid, lane = tid & 63, wid = tid >> 6, wr = wid >> 1, wc = wid & 1, fr = lane & 15, fq = lane >> 4;
    for (int it = cx.bid; it < 3200; it += cx.G) {
#ifndef B1MASK
#define B1MASK 7
#endif
        if (it < 1536) { if (B1MASK & 1) chunk_item<64, 0>(cx, p, l, it, lds); }
        else if (it < 3072) { if (B1MASK & 2) chunk_item<32, 0>(cx, p, l, it - 1536, lds); }
        else if (B1MASK & 4) {
            const int it2 = it - 3072, g = it2 >> 3, rt = it2 & 7;
            f32x4 acc[2][4];
            gemm128(cx, (const bf16_t*)(p.ws + O_AS5) + (size_t)g * 1024 * 384, 384, (const bf16_t*)(p.ws + O_BTS5S) + (size_t)(l * 16 + g) * 128 * 256, 256, 256, rt * 128, 0, lds, acc);
            float* S5S = (float*)(p.ws + O_S5S);
#pragma unroll
            for (int mi = 0; mi < 2; ++mi)
#pragma unroll
                for (int ni = 0; ni < 4; ++ni) {
                    const int ch = rt * 128 + wr * 32 + mi * 16 + fr, n = wc * 64 + ni * 16 + 4 * fq;
                    *(f32x4*)(S5S + ((size_t)g * 1024 + ch) * 128 + n) = acc[mi][ni];
                }
        }
    }
}

DEV void phase_b3(const Ctx cx, const P& p, int l, unsigned char* lds) {
    const int tid = cx.tid, lane = tid & 63, wid = tid >> 6, wr = wid >> 1, wc = wid & 1, fr = lane & 15, fq = lane >> 4;
    for (int it = cx.bid; it < 3328; it += cx.G) {
        if (it < 1536) chunk_item<64, 1>(cx, p, l, it, lds);
        else if (it < 3072) chunk_item<32, 1>(cx, p, l, it - 1536, lds);
        else {
            const int it2 = it - 3072, g = it2 >> 4, rt = (it2 & 15) >> 1, ct = it2 & 1;
            f32x4 acc[2][4];
            gemm128(cx, (const bf16_t*)(p.ws + O_AS5) + (size_t)g * 1024 * 384, 384, (const bf16_t*)(p.ws + O_BTS5Y) + (size_t)(l * 16 + g) * 256 * 384, 384, 384, rt * 128, ct * 128, lds, acc);
            bf16_t* YG = (bf16_t*)(p.ws + O_S5S);
#pragma unroll
            for (int mi = 0; mi < 2; ++mi)
#pragma unroll
                for (int ni = 0; ni < 4; ++ni) {
                    const int ch = rt * 128 + wr * 32 + mi * 16 + fr, n = ct * 128 + wc * 64 + ni * 16 + 4 * fq, i = n >> 4, c = n & 15;
                    const f32x4 a = acc[mi][ni];
                    st4bf(YG + ((size_t)ch * 16 + i) * 256 + g * 16 + c, (f32x4){geluf_(a[0]), geluf_(a[1]), geluf_(a[2]), geluf_(a[3])});
                }
        }
    }
}

DEV void phase_b4(const Ctx cx, const P& p, int l, unsigned char* lds) {
    const int tid = cx.tid, lane = tid & 63, wid = tid >> 6, wr = wid >> 1, wc = wid & 1, fr = lane & 15, fq = lane >> 4;
    const bf16_t* YG = (const bf16_t*)(p.ws + O_S5S);
    for (int it = cx.bid; it < 256; it += cx.G) {
        const int rt = it >> 1, ct = it & 1;
        f32x4 acc[2][4];
        gemm128(cx, YG, 256, (const bf16_t*)(p.ws + O_BTGLU) + (size_t)l * 65536, 256, 256, rt * 128, ct * 128, lds, acc);
#pragma unroll
        for (int mi = 0; mi < 2; ++mi)
#pragma unroll
            for (int ni = 0; ni < 4; ++ni) {
                const int tok = rt * 128 + wr * 32 + mi * 16 + fr, n = ct * 128 + wc * 64 + ni * 16 + 4 * fq;
                const f32x4 bg = *(const f32x4*)(p.in[22] + l * 256 + n);
                const u32x2 yw = *(const u32x2*)(YG + (size_t)tok * 256 + n);
                const u32x2 zw = *(const u32x2*)((const bf16_t*)(p.ws + O_SZ) + (size_t)tok * 256 + n);
                const f32x4 a = acc[mi][ni] + bg;
                f32x4 r; r[0] = bflo(yw.x) * sigmoidf_(a[0]) * bflo(zw.x); r[1] = bfhi(yw.x) * sigmoidf_(a[1]) * bfhi(zw.x);
                r[2] = bflo(yw.y) * sigmoidf_(a[2]) * bflo(zw.y); r[3] = bfhi(yw.y) * sigmoidf_(a[3]) * bfhi(zw.y);
                st4bf((bf16_t*)(p.ws + O_MIX) + (size_t)tok * 1024 + 768 + n, r);
            }
    }
}

template <int DK>
DEV void scan_item(const Ctx cx, const P& p, int l, int wi) {
    constexpr bool GLA = (DK == 32);
    constexpr int WPB = (64 * DK) / 256;
    const int lane = cx.tid & 63;
    const int bh = wi / WPB, sub = wi - bh * WPB, e0 = sub * 256 + lane * 4, v = e0 / DK, k = e0 % DK;
    const float* DD = (const float*)(p.ws + (GLA ? O_DDG : O_DDH));
    bf16_t* DS = (bf16_t*)(p.ws + (GLA ? O_DSG : O_DSH));
    f32x4 S = (f32x4){0.f, 0.f, 0.f, 0.f};
    for (int c = 0; c < 32; ++c) {
        const size_t item = (size_t)bh * 32 + c;
        const f32x4 d = *(const f32x4*)(DD + item * DK + k);
        bf16_t* ptr = DS + item * 64 * DK + e0;
        const u32x2 w = *(const u32x2*)ptr;
        st4bf(ptr, S);
        S[0] = d[0] * S[0] + bflo(w.x); S[1] = d[1] * S[1] + bfhi(w.x); S[2] = d[2] * S[2] + bflo(w.y); S[3] = d[3] * S[3] + bfhi(w.y);
    }
    float* o = p.out + (GLA ? OUT_GP : OUT_HP) + ((size_t)l * 48 + bh) * DK * 64;
#pragma unroll
    for (int e = 0; e < 4; ++e) o[(k + e) * 64 + v] = S[e];
}

DEV void s5_scan_item(const Ctx cx, const P& p, int l, int wi) {
    const int lane = cx.tid & 63, b = wi >> 4, g = wi & 15;
    const float* A16 = (const float*)(p.ws + O_A16) + ((l * 16 + g) * 64 + lane) * 2;
    const float ar = A16[0], ai = A16[1];
    const float* S5S = (const float*)(p.ws + O_S5S) + ((size_t)g * 1024 + b * 128) * 128;
    bf16_t* AS5 = (bf16_t*)(p.ws + O_AS5) + ((size_t)g * 1024 + b * 128) * 384 + 256;
    float xr = 0.f, xi = 0.f;
    for (int c = 0; c < 128; ++c) {
        AS5[(size_t)c * 384 + lane] = f2bf(xr); AS5[(size_t)c * 384 + 64 + lane] = f2bf(xi);
        const float sr = S5S[c * 128 + lane], si = S5S[c * 128 + 64 + lane];
        const float nr = ar * xr - ai * xi + sr, ni = ar * xi + ai * xr + si;
        xr = nr; xi = ni;
    }
    p.out[OUT_RP + ((size_t)(l * 8 + b) * 16 + g) * 64 + lane] = xr;
    p.out[OUT_IP + ((size_t)(l * 8 + b) * 16 + g) * 64 + lane] = xi;
}

template <int DK>
DEV void sample_rec_item(const Ctx cx, const P& p, int l, int wi) {
    constexpr bool GLA = (DK == 32);
    const int lane = cx.tid & 63, j = wi / 6, h = wi - j * 6; const size_t row = TP + j;
    unsigned char* ws = p.ws;
    float fk, kk_, qk;
    if (!GLA) {
        const float g = ((const float*)(ws + O_HG))[row * 384 + h * 64 + lane];
        fk = __expf(g); kk_ = 1.0f - fk; qk = bf2f(((const bf16_t*)(ws + O_HQ))[row * 384 + h * 64 + lane]);
    } else {
        const int k = lane & 31;
        float a = p.in[11][l * 192 + h * 32 + k];
        const float* rb = (const float*)(ws + O_GR) + row * 16;
#pragma unroll
        for (int r = 0; r < 16; ++r) a += rb[r] * p.in[10][(l * 16 + r) * 192 + h * 32 + k];
        fk = __expf(logsigf_(a) * (1.0f / 16.0f));
        kk_ = bf2f(((const bf16_t*)(ws + O_GQ))[row * 384 + h * 64 + 32 + k]); qk = bf2f(((const bf16_t*)(ws + O_GQ))[row * 384 + h * 64 + k]);
    }
    const float vv = bf2f(((const bf16_t*)(ws + (GLA ? O_GV : O_HV)))[row * 384 + h * 64 + lane]);
    const float* S0 = p.in[GLA ? 3 : 2] + (((size_t)l * 128 + j) * 6 + h) * DK * 64;
    float* S1 = p.out + (GLA ? OUT_GS : OUT_HS) + (((size_t)l * 128 + j) * 6 + h) * DK * 64;
    float o = 0.f;
#pragma unroll 8
    for (int k = 0; k < DK; ++k) {
        const float f = __shfl(fk, k), kq = __shfl(kk_, k), qq = __shfl(qk, k);
        const float sn = f * S0[k * 64 + lane] + kq * vv;
        S1[k * 64 + lane] = sn; o += qq * sn;
    }
    const float ss = wave_sum(o * o), sc = rsqrtf(ss * (1.0f / 64.0f) + EPS);
    const float gn = p.in[GLA ? 12 : 9][l * 384 + h * 64 + lane];
    const float z = bf2f(((const bf16_t*)(ws + (GLA ? O_GZ : O_HZ)))[row * 384 + h * 64 + lane]);
    ((bf16_t*)(ws + O_MIX))[row * 1024 + (GLA ? 384 : 0) + h * 64 + lane] = f2bf(o * sc * gn * z);
}

DEV void sample_s5_item(const Ctx cx, const P& p, int l, int j, float* ygs  ) {
    const int lane = cx.tid & 63; const size_t row = TP + j;
    unsigned char* ws = p.ws;
    const float* u = (const float*)(ws + O_SUS) + (size_t)j * 256;
    for (int g = 0; g < 16; ++g) {
        const int lg = l * 16 + g;
        const float* AB = (const float*)(ws + O_ABAR) + (lg * 64 + lane) * 2;
        const float* BB = (const float*)(ws + O_BB) + ((size_t)(lg * 64 + lane) * 16) * 2;
        const float x0r = p.in[4][(((size_t)l * 128 + j) * 16 + g) * 64 + lane], x0i = p.in[5][(((size_t)l * 128 + j) * 16 + g) * 64 + lane];
        float xr = AB[0] * x0r - AB[1] * x0i, xi = AB[0] * x0i + AB[1] * x0r;
#pragma unroll
        for (int c = 0; c < 16; ++c) { const float uu = u[g * 16 + c]; xr += BB[c * 2] * uu; xi += BB[c * 2 + 1] * uu; }
        p.out[OUT_RS + (((size_t)l * 128 + j) * 16 + g) * 64 + lane] = xr;
        p.out[OUT_IS + (((size_t)l * 128 + j) * 16 + g) * 64 + lane] = xi;
#pragma unroll
        for (int c = 0; c < 16; ++c) {
            float part = p.in[17][((size_t)lg * 16 + c) * 64 + lane] * xr - p.in[18][((size_t)lg * 16 + c) * 64 + lane] * xi;
            part = wave_sum(part);
            const float y = part + p.in[19][l * 256 + g * 16 + c] * u[g * 16 + c];
            if (lane == c) ygs[g * 16 + c] = geluf_(y);
        }
    }
    __builtin_amdgcn_wave_barrier();
    asm volatile("s_waitcnt lgkmcnt(0)" ::: "memory");
    f32x4 acc = *(const f32x4*)(p.in[22] + l * 256 + lane * 4);
    const float* W = p.in[21] + (size_t)l * 65536 + lane * 4;
    for (int i = 0; i < 256; ++i) { const float yv = ygs[i]; const f32x4 w = *(const f32x4*)(W + (size_t)i * 256); acc += w * yv; }
    const f32x4 yq = *(const f32x4*)(ygs + lane * 4);
    const u32x2 zw = *(const u32x2*)((const bf16_t*)(ws + O_SZ) + row * 256 + lane * 4);
    f32x4 r; r[0] = yq[0] * sigmoidf_(acc[0]) * bflo(zw.x); r[1] = yq[1] * sigmoidf_(acc[1]) * bfhi(zw.x); r[2] = yq[2] * sigmoidf_(acc[2]) * bflo(zw.y); r[3] = yq[3] * sigmoidf_(acc[3]) * bfhi(zw.y);
    st4bf((bf16_t*)(ws + O_MIX) + row * 1024 + 768 + lane * 4, r);
    asm volatile("s_waitcnt lgkmcnt(0)" ::: "memory");
}

DEV void phase_b2(const Ctx cx, const P& p, int l, unsigned char* lds) {
    const int wid = cx.tid >> 6;
    float* ygs = (float*)lds + wid * 256;
    const int TW = cx.G * 8;
    for (int it = cx.bid + cx.G * wid; it < 2944; it += TW) {
        if (it < 128) s5_scan_item(cx, p, l, it);
        else if (it < 256) sample_s5_item(cx, p, l, it - 128, ygs);
        else if (it < 1024) scan_item<64>(cx, p, l, it - 256);
        else if (it < 1408) scan_item<32>(cx, p, l, it - 1024);
        else if (it < 2176) sample_rec_item<64>(cx, p, l, it - 1408);
        else sample_rec_item<32>(cx, p, l, it - 2176);
    }
}

DEV void phase_outproj(const Ctx cx, const P& p, int l, unsigned char* lds) {
    const int tid = cx.tid, lane = tid & 63, wid = tid >> 6, wr = wid >> 1, wc = wid & 1, fr = lane & 15, fq = lane >> 4;
    const bf16_t* MIX = (const bf16_t*)(p.ws + O_MIX);
    const bf16_t* Bt = (const bf16_t*)(p.ws + O_BTOUT) + (size_t)l * D * D;
    bf16_t* AX = (bf16_t*)(p.ws + O_AX); float* RSQ = (float*)(p.ws + O_RSQ);
    for (int it = cx.bid; it < 129 * 8; it += cx.G) {
        const int rt = it >> 3, ct = it & 7;
        f32x4 acc[2][4];
        gemm128(cx, MIX, D, Bt, D, D, rt * 128, ct * 128, lds, acc);
#pragma unroll
        for (int mi = 0; mi < 2; ++mi) {
            const int row = rt * 128 + wr * 32 + mi * 16 + fr;
            const float* res = (l == 0) ? (row < TP ? p.in[0] + (size_t)row * D : p.in[1] + (size_t)(row - TP) * D) : p.out + (size_t)row * D;
            float ss = 0.f;
#pragma unroll
            for (int ni = 0; ni < 4; ++ni) {
                const int col = ct * 128 + wc * 64 + ni * 16 + 4 * fq;
                const f32x4 x = *(const f32x4*)(res + col) + acc[mi][ni];
                *(f32x4*)(p.out + (size_t)row * D + col) = x;
                st4bf(AX + (size_t)row * D + col, x);
                ss += x[0] * x[0] + x[1] * x[1] + x[2] * x[2] + x[3] * x[3];
            }
            ss += __shfl_xor(ss, 16); ss += __shfl_xor(ss, 32);
            if (fq == 0) RSQ[row * 16 + ct * 2 + wc] = ss;
        }
    }
}

DEV void phase_final(const Ctx cx, const P& p) {
    const int lane = cx.tid & 63, wid = cx.tid >> 6;
    const float* RSQ = (const float*)(p.ws + O_RSQ);
    for (int row = cx.bid * 8 + wid; row < MT; row += cx.G * 8) {
        float ss = 0.f;
#pragma unroll
        for (int i = 0; i < 4; ++i) { const f32x4 q = *(const f32x4*)(RSQ + row * 16 + i * 4); ss += q[0] + q[1] + q[2] + q[3]; }
        const float r = rsqrtf(ss * (1.0f / 1024.0f) + EPS);
        float* x = p.out + (size_t)row * D;
#pragma unroll
        for (int i = 0; i < 4; ++i) {
            const int col = i * 256 + lane * 4;
            const f32x4 g = *(const f32x4*)(p.in[24] + col);
            *(f32x4*)(x + col) = *(const f32x4*)(x + col) * r * g;
        }
    }
}

__global__ void __launch_bounds__(NTHR) hymba_fwd(P p) {
    __shared__ __attribute__((aligned(16))) unsigned char lds[LDS_BYTES];
    cg::grid_group grid = cg::this_grid();
    for (int ph = p.ph_lo; ph < p.ph_hi; ++ph) {
        Ctx cx; { int t_ = threadIdx.x, b_ = blockIdx.x, g_ = gridDim.x; asm volatile("" : "+v"(t_)); asm volatile("" : "+s"(b_)); asm volatile("" : "+s"(g_)); cx.tid = t_; cx.bid = b_; cx.G = g_; }
#ifndef PHMASK
#define PHMASK 0xff
#endif
        if (ph == 0) { if (PHMASK & 1) phase_prep(cx, p, lds); }
        else if (ph == NPHASE - 1) { if (PHMASK & 2) phase_final(cx, p); }
        else {
            const int l = (ph - 1) / 6, s = (ph - 1) % 6;
            if (s == 0) { if (PHMASK & 4) phase_inproj(cx, p, l, lds); }
            else if (s == 1) { if (PHMASK & 8) phase_b1(cx, p, l, lds); }
            else if (s == 2) { if (PHMASK & 16) phase_b2(cx, p, l, lds); }
            else if (s == 3) { if (PHMASK & 32) phase_b3(cx, p, l, lds); }
            else if (s == 4) { if (PHMASK & 64) phase_b4(cx, p, l, lds); }
            else { if (PHMASK & 128) phase_outproj(cx, p, l, lds); }
        }
        if (ph + 1 < p.ph_hi) grid.sync();
    }
#ifdef STOPAT
    grid.sync();
    {
        const int lane = threadIdx.x & 63, wid = threadIdx.x >> 6;
        const int nchunk = (int)(O_END / 65536);
        for (int c = blockIdx.x * 8 + wid; c < nchunk; c += gridDim.x * 8) {
            const unsigned* w = (const unsigned*)(p.ws + (size_t)c * 65536);
            unsigned sum = 0;
            for (int i = lane; i < 16384; i += 64) sum += w[i] * (unsigned)(i * 2 + 1);
            for (int o = 32; o >= 1; o >>= 1) sum += __shfl_xor(sum, o);
            if (lane == 0) p.out[c] = (float)(sum & 0xffffffu);
        }
    }
#endif
}

extern "C" void kernel_launch(void* const* d_in, const int* in_sizes, int n_in, void* d_out, int out_size, void* d_ws, size_t ws_size, hipStream_t stream) {
    static int grid_blocks = 0;
    if (grid_blocks == 0) {
        if (n_in != 25 || ws_size < O_END) { fprintf(stderr, "kernel_launch: unexpected n_in %d or workspace %zu < %zu\n", n_in, ws_size, (size_t)O_END); grid_blocks = -1; return; }
        int dev = 0, cus = 0, per_cu = 0;
        (void)hipGetDevice(&dev);
        (void)hipDeviceGetAttribute(&cus, hipDeviceAttributeMultiprocessorCount, dev);
        (void)hipOccupancyMaxActiveBlocksPerMultiprocessor(&per_cu, (const void*)hymba_fwd, NTHR, 0);
        if (per_cu < 1) { fprintf(stderr, "kernel_launch: occupancy query gave %d\n", per_cu); per_cu = 1; }
        grid_blocks = cus * 1;
        (void)hipGetLastError();
    }
    if (grid_blocks < 0) return;
    P p{};
    for (int i = 0; i < 25; ++i) p.in[i] = (const float*)d_in[i];
    p.out = (float*)d_out; p.ws = (unsigned char*)d_ws;
#if MEGA
#ifdef STOPAT
    p.ph_lo = 0; p.ph_hi = STOPAT;
#else
    p.ph_lo = 0; p.ph_hi = NPHASE;
#endif
    void* args[] = {&p};
    hipError_t e = hipLaunchCooperativeKernel((const void*)hymba_fwd, dim3(grid_blocks), dim3(NTHR), args, 0, stream);
    if (e != hipSuccess) fprintf(stderr, "cooperative launch failed: %s (grid %d)\n", hipGetErrorString(e), grid_blocks);
#else
    for (int ph = 0; ph < NPHASE; ++ph) {
        p.ph_lo = ph; p.ph_hi = ph + 1;
        hipLaunchKernelGGL(hymba_fwd, dim3(grid_blocks), dim3(NTHR), 0, stream, p);
    }
#endif
}
```

```cpp
#include <hip/hip_runtime.h>
#include <hip/hip_cooperative_groups.h>
#include <cstdio>
#include <cstdint>
namespace cg = cooperative_groups;

#define REPMASK 0
#ifndef MEGA
#define MEGA 1
#endif

typedef unsigned short bf16_t;
typedef short bf16x8 __attribute__((ext_vector_type(8)));
typedef float f32x4 __attribute__((ext_vector_type(4)));
typedef unsigned u32x4 __attribute__((ext_vector_type(4)));
typedef unsigned u32x2 __attribute__((ext_vector_type(2)));
#define DEV __device__ __forceinline__

constexpr int D = 1024, TP = 16384, TS = 128, MT = 16512, MPAD = 16640, NIN = 3216, NPERM = 3584;
constexpr float EPS = 1e-6f;
constexpr int NTHR = 512;
constexpr int LDS_BYTES = 144 * 1024;
constexpr int NPHASE = 14;

constexpr size_t al(size_t x) { return (x + 255) & ~size_t(255); }
constexpr size_t O_BTIN = 0;
constexpr size_t O_BTOUT = O_BTIN + al(2ull * NPERM * 1024 * 2);
constexpr size_t O_BTGLU = O_BTOUT + al(2ull * 1024 * 1024 * 2);
constexpr size_t O_BTS5Y = O_BTGLU + al(2ull * 256 * 256 * 2);
constexpr size_t O_BTS5S = O_BTS5Y + al(2ull * 16 * 256 * 384 * 2);
constexpr size_t O_A16 = O_BTS5S + al(2ull * 16 * 128 * 256 * 2);
constexpr size_t O_ABAR = O_A16 + al(2ull * 16 * 64 * 2 * 4);
constexpr size_t O_BB = O_ABAR + al(2ull * 16 * 64 * 2 * 4);
constexpr size_t O_LB = O_BB + al(2ull * 16 * 64 * 16 * 2 * 4);
constexpr size_t O_AX = O_LB + al(2ull * 384 * 4);
constexpr size_t O_RSQ = O_AX + al((size_t)MPAD * 1024 * 2);
constexpr size_t O_HQ = O_RSQ + al((size_t)MPAD * 16 * 4);
constexpr size_t O_HV = O_HQ + al((size_t)MPAD * 384 * 2);
constexpr size_t O_HZ = O_HV + al((size_t)MPAD * 384 * 2);
constexpr size_t O_HG = O_HZ + al((size_t)MPAD * 384 * 2);
constexpr size_t O_GQ = O_HG + al((size_t)MPAD * 384 * 4);
constexpr size_t O_GV = O_GQ + al((size_t)MPAD * 384 * 2);
constexpr size_t O_GZ = O_GV + al((size_t)MPAD * 384 * 2);
constexpr size_t O_GR = O_GZ + al((size_t)MPAD * 384 * 2);
constexpr size_t O_AS5 = O_GR + al((size_t)MPAD * 192 * 4);
constexpr size_t O_SUS = O_AS5 + al(16ull * 1024 * 384 * 2);
constexpr size_t O_YGS = O_SUS + al(128ull * 256 * 4);
constexpr size_t O_SZ = O_YGS + al(128ull * 256 * 2);
constexpr size_t O_MIX = O_SZ + al((size_t)MPAD * 256 * 2);
constexpr size_t O_DSH = O_MIX + al((size_t)MPAD * 1024 * 2);
constexpr size_t O_DDH = O_DSH + al(1536ull * 4096 * 2);
constexpr size_t O_DSG = O_DDH + al(1536ull * 64 * 4);
constexpr size_t O_DDG = O_DSG + al(1536ull * 2048 * 2);
constexpr size_t O_S5S = O_DDG + al(1536ull * 32 * 4);
constexpr size_t O_BAR = O_S5S + al(16ull * 1024 * 128 * 4);
constexpr size_t O_PART = O_BAR + 256;
constexpr size_t O_XBAR = O_PART + al(4ull * 128 * 1024 * 4);
constexpr size_t O_FX = O_XBAR + al(3456 * 4);
constexpr size_t O_FCNT = O_FX + al(16384ull * 4 * 4);
constexpr size_t O_END = O_FCNT + 64 * 256;

constexpr size_t OUT_YS = 16777216, OUT_HP = 16908288, OUT_GP = 17301504, OUT_RP = 17498112, OUT_IP = 17514496,
                 OUT_HS = 17530880, OUT_GS = 23822336, OUT_RS = 26968064, OUT_IS = 27230208;

struct P {
    const float* in[25];
    float* out;
    unsigned char* ws;
    int ph_lo, ph_hi;
};

struct Ctx { int tid, bid, G; };

DEV void lds_barrier() { asm volatile("s_waitcnt lgkmcnt(0)" ::: "memory"); __builtin_amdgcn_s_barrier(); asm volatile("" ::: "memory"); }
DEV u32x4 rot8h(u32x4 w, int r) {
    if (r & 4) w = (u32x4){w.z, w.w, w.x, w.y};
    if (r & 2) w = (u32x4){w.y, w.z, w.w, w.x};
    if (r & 1) w = (u32x4){__builtin_amdgcn_alignbit(w.y, w.x, 16), __builtin_amdgcn_alignbit(w.z, w.y, 16), __builtin_amdgcn_alignbit(w.w, w.z, 16), __builtin_amdgcn_alignbit(w.x, w.w, 16)};
    return w;
}
DEV u32x2 rot4h(u32x2 w, int r) {
    if (r & 2) w = (u32x2){w.y, w.x};
    if (r & 1) w = (u32x2){__builtin_amdgcn_alignbit(w.y, w.x, 16), __builtin_amdgcn_alignbit(w.x, w.y, 16)};
    return w;
}
DEV int vslot(int v) { return (v & ~31) + ((v >> 2) & 1) * 16 + ((v >> 3) & 3) * 4 + (v & 3); }
DEV Ctx relaunder(Ctx c) { asm volatile("" : "+v"(c.tid)); return c; }

typedef __bf16 bf16x2_t __attribute__((ext_vector_type(2)));
typedef float f32x2_t __attribute__((ext_vector_type(2)));
DEV unsigned cvt_pk(float lo, float hi) { const f32x2_t f = {lo, hi}; const bf16x2_t b = __builtin_convertvector(f, bf16x2_t); return __builtin_bit_cast(unsigned, b); }
DEV void st4bf(bf16_t* dst, f32x4 v) { u32x2 w; w.x = cvt_pk(v[0], v[1]); w.y = cvt_pk(v[2], v[3]); *(u32x2*)dst = w; }
DEV bf16_t f2bf(float f) { return (bf16_t)(cvt_pk(f, 0.f) & 0xffffu); }
DEV float bf2f(bf16_t b) { return __uint_as_float(((unsigned)b) << 16); }
DEV float bflo(unsigned w) { return __uint_as_float(w << 16); }
DEV float bfhi(unsigned w) { return __uint_as_float(w & 0xffff0000u); }
DEV float wave_sum(float v) {
#pragma unroll
    for (int o = 32; o >= 1; o >>= 1) v += __shfl_xor(v, o);
    return v;
}
DEV float rcpf_(float x) { return __builtin_amdgcn_rcpf(x); }
DEV float sigmoidf_(float x) { return rcpf_(1.0f + __expf(-x)); }
DEV float siluf_(float x) { return x * sigmoidf_(x); }
DEV float logsigf_(float x) { return fminf(x, 0.f) - log1pf(__expf(-fabsf(x))); }
DEV float geluf_(float x) { const float u = 0.7978845608028654f * (x + 0.044715f * x * x * x); const float t = 1.0f - 2.0f * rcpf_(1.0f + __expf(2.0f * u)); return 0.5f * x * (1.0f + t); }
DEV float expc(float x) { return __expf(fminf(x, 80.f)); }

DEV int perm_src(int np) {
    const int pn = np >> 8, j = np & 255;
    if (pn < 6) return (j >> 6) * 384 + pn * 64 + (j & 63);
    if (pn < 12) {
        const int h = pn - 6;
        if (j < 32) return 1536 + h * 32 + j;
        if (j < 64) return 1728 + h * 32 + (j - 32);
        if (j < 128) return 1920 + h * 64 + (j - 64);
        if (j < 192) return 2304 + h * 64 + (j - 128);
        if (j < 224) return -2 - (h * 32 + (j - 192));
        return -1;
    }
    if (pn == 12) return 2704 + j;
    return 2960 + j;
}

DEV void cis_d(double th, double& c, double& s) {
    const double n = rint(th * 0.15915494309189535);
    double r = fma(-n, 6.283185307179586, th); r = fma(-n, 2.4492935982947064e-16, r);
    const double x = r * (1.0 / 64.0), x2 = x * x;
    double sn = x * (1.0 - x2 * (1.0 / 6.0) * (1.0 - x2 * (1.0 / 20.0) * (1.0 - x2 * (1.0 / 42.0) * (1.0 - x2 * (1.0 / 72.0)))));
    double cs = 1.0 - x2 * 0.5 * (1.0 - x2 * (1.0 / 12.0) * (1.0 - x2 * (1.0 / 30.0) * (1.0 - x2 * (1.0 / 56.0) * (1.0 - x2 * (1.0 / 90.0)))));
#pragma unroll
    for (int i = 0; i < 6; ++i) { const double c2 = cs * cs - sn * sn, s2 = 2.0 * cs * sn; cs = c2; sn = s2; }
    c = cs; s = sn;
}

template <int NK>
DEV void gemm128(const Ctx cx, const bf16_t* __restrict__ A, int lda, const bf16_t* __restrict__ Bt, int ldb, int row0, int col0,
                 unsigned char* lds, f32x4 (&acc)[2][4]) {
    constexpr int LS = 136;
    const int tid = cx.tid, lane = tid & 63, wid = tid >> 6, wr = wid >> 1, wc = wid & 1, fr = lane & 15, fq = lane >> 4;
    bf16_t* sA = (bf16_t*)lds;
    bf16_t* sB = sA + 128 * LS;
    const int r0 = tid >> 4, c0 = (tid & 15) * 8;
    const bf16_t* pa = A + (size_t)(row0 + r0) * lda + c0;
    const bf16_t* pb = Bt + (size_t)(col0 + r0) * ldb + c0;
#pragma unroll
    for (int mi = 0; mi < 2; ++mi)
#pragma unroll
        for (int ni = 0; ni < 4; ++ni) acc[mi][ni] = (f32x4){0.f, 0.f, 0.f, 0.f};
    u32x4 ra[NK][4], rb[NK][4];
#pragma unroll
    for (int s = 0; s < NK; ++s)
#pragma unroll
        for (int i = 0; i < 4; ++i) { ra[s][i] = *(const u32x4*)(pa + (size_t)(32 * i) * lda + s * 128); rb[s][i] = *(const u32x4*)(pb + (size_t)(32 * i) * ldb + s * 128); }
#pragma unroll
    for (int s = 0; s < NK; ++s) {
        lds_barrier();
#pragma unroll
        for (int i = 0; i < 4; ++i) { *(u32x4*)(sA + (r0 + 32 * i) * LS + c0) = ra[s][i]; *(u32x4*)(sB + (r0 + 32 * i) * LS + c0) = rb[s][i]; }
        lds_barrier();
#pragma unroll
        for (int kk = 0; kk < 4; ++kk) {
            bf16x8 af[2], bfr[4];
#pragma unroll
            for (int mi = 0; mi < 2; ++mi) af[mi] = *(const bf16x8*)(sA + (wr * 32 + mi * 16 + fr) * LS + kk * 32 + fq * 8);
#pragma unroll
            for (int ni = 0; ni < 4; ++ni) bfr[ni] = *(const bf16x8*)(sB + (wc * 64 + ni * 16 + fr) * LS + kk * 32 + fq * 8);
#pragma unroll
            for (int mi = 0; mi < 2; ++mi)
#pragma unroll
                for (int ni = 0; ni < 4; ++ni) acc[mi][ni] = __builtin_amdgcn_mfma_f32_16x16x32_bf16(bfr[ni], af[mi], acc[mi][ni], 0, 0, 0);
        }
    }
}

DEV void s5_precompute(const Ctx cx, const P& p, int it, unsigned char* lds) {
    const int tid = cx.tid;
    const int l = it >> 4, g = it & 15, lg = it;
    float* Ap = (float*)lds;
    float* Bbs = Ap + 17 * 64 * 2;
    float* Cs = Bbs + 64 * 16 * 2;
    float* Km = Cs + 16 * 64 * 2;
    unsigned char* ws = p.ws;
    __syncthreads();
    const float dt = expf(p.in[20][lg]);
    for (int e = tid; e < 17 * 64; e += NTHR) {
        const int j = e >> 6, pp = e & 63;
        const float lr = p.in[13][lg * 64 + pp], li = p.in[14][lg * 64 + pp];
        const float mag = expf((float)j * lr * dt);
        double c, s; cis_d((double)li * (double)dt * (double)j, c, s);
        Ap[e * 2] = mag * (float)c; Ap[e * 2 + 1] = mag * (float)s;
    }
    __syncthreads();
    float* BBg = (float*)(ws + O_BB);
    for (int e = tid; e < 64 * 16; e += NTHR) {
        const int pp = e >> 4, cc = e & 15;
        const float lr = p.in[13][lg * 64 + pp], li = p.in[14][lg * 64 + pp];
        const float abr = Ap[(64 + pp) * 2], abi = Ap[(64 + pp) * 2 + 1], nr = abr - 1.0f, den = lr * lr + li * li;
        const float cor = (nr * lr + abi * li) / den, coi = (abi * lr - nr * li) / den;
        const float Br = p.in[15][(lg * 64 + pp) * 16 + cc], Bi = p.in[16][(lg * 64 + pp) * 16 + cc];
        const float bbr = cor * Br - coi * Bi, bbi = cor * Bi + coi * Br;
        Bbs[e * 2] = bbr; Bbs[e * 2 + 1] = bbi;
        BBg[((size_t)(lg * 64 + pp) * 16 + cc) * 2] = bbr; BBg[((size_t)(lg * 64 + pp) * 16 + cc) * 2 + 1] = bbi;
    }
    for (int e = tid; e < 16 * 64; e += NTHR) {
        const int cc = e >> 6, pp = e & 63;
        Cs[e * 2] = p.in[17][(lg * 16 + cc) * 64 + pp]; Cs[e * 2 + 1] = p.in[18][(lg * 16 + cc) * 64 + pp];
    }
    if (tid < 64) {
        float* A16 = (float*)(ws + O_A16); float* AB = (float*)(ws + O_ABAR);
        A16[(lg * 64 + tid) * 2] = Ap[(16 * 64 + tid) * 2]; A16[(lg * 64 + tid) * 2 + 1] = Ap[(16 * 64 + tid) * 2 + 1];
        AB[(lg * 64 + tid) * 2] = Ap[(64 + tid) * 2]; AB[(lg * 64 + tid) * 2 + 1] = Ap[(64 + tid) * 2 + 1];
    }
    __syncthreads();
    for (int e = tid; e < 4096; e += NTHR) {
        const int j = e >> 8, c = (e >> 4) & 15, c2 = e & 15;
        float acc = 0.f;
        for (int pp = 0; pp < 64; ++pp) {
            const float cr = Cs[(c * 64 + pp) * 2], ci = Cs[(c * 64 + pp) * 2 + 1], ar = Ap[(j * 64 + pp) * 2], ai = Ap[(j * 64 + pp) * 2 + 1];
            const float br = Bbs[(pp * 16 + c2) * 2], bi = Bbs[(pp * 16 + c2) * 2 + 1];
            const float car = cr * ar - ci * ai, cai = cr * ai + ci * ar;
            acc += car * br - cai * bi;
        }
        if (j == 0 && c == c2) acc += p.in[19][l * 256 + g * 16 + c];
        Km[e] = acc;
    }
    __syncthreads();
    bf16_t* Y = (bf16_t*)(ws + O_BTS5Y) + (size_t)lg * 256 * 384;
    for (int e = tid; e < 256 * 384; e += NTHR) {
        const int n = e / 384, k = e - n * 384, i = n >> 4, c = n & 15;
        float v;
        if (k < 256) { const int j = k >> 4, c2 = k & 15; v = (j <= i) ? Km[((i - j) * 16 + c) * 16 + c2] : 0.f; }
        else { const int pp = (k - 256) & 63, imf = (k - 256) >> 6;
            const float cr = Cs[(c * 64 + pp) * 2], ci = Cs[(c * 64 + pp) * 2 + 1], ar = Ap[((i + 1) * 64 + pp) * 2], ai = Ap[((i + 1) * 64 + pp) * 2 + 1];
            v = imf ? -(cr * ai + ci * ar) : (cr * ar - ci * ai); }
        Y[e] = f2bf(v);
    }
    bf16_t* S = (bf16_t*)(ws + O_BTS5S) + (size_t)lg * 128 * 256;
    for (int e = tid; e < 128 * 256; e += NTHR) {
        const int n = e >> 8, k = e & 255, pp = n & 63, imf = n >> 6, j = k >> 4, c2 = k & 15;
        const float ar = Ap[((15 - j) * 64 + pp) * 2], ai = Ap[((15 - j) * 64 + pp) * 2 + 1], br = Bbs[(pp * 16 + c2) * 2], bi = Bbs[(pp * 16 + c2) * 2 + 1];
        S[e] = f2bf(imf ? (ar * bi + ai * br) : (ar * br - ai * bi));
    }
}

DEV void phase_prep(const Ctx cx, const P& p, unsigned char* lds, int part, int vb, int VG) {
    const int tid = cx.tid, lane = tid & 63, wid = tid >> 6;
    unsigned char* ws = p.ws;
    int G = VG, bid = vb;
    if (part != 0) {
        const bool split = VG > 64;
        if (!split || vb < 32) for (int it = vb; it < 32; it += VG) s5_precompute(cx, p, it, lds);
        if (split && vb < 32) return;
        if (split) { G = VG - 32; bid = vb - 32; }
    }
    if (part != 1)
    {
        bf16_t* AX = (bf16_t*)(ws + O_AX); float* RSQ = (float*)(ws + O_RSQ);
        for (int row0 = (bid * 8 + wid) * 4; row0 < MPAD; row0 += G * 32) {
            f32x4 v[4][4];
#pragma unroll
            for (int rr = 0; rr < 4; ++rr) {
                const int row = row0 + rr;
                const float* src = row < TP ? p.in[0] + (size_t)row * D : (row < MT ? p.in[1] + (size_t)(row - TP) * D : nullptr);
#pragma unroll
                for (int i = 0; i < 4; ++i) { v[rr][i] = (f32x4){0.f, 0.f, 0.f, 0.f}; if (src) v[rr][i] = __builtin_nontemporal_load((const f32x4*)(src + i * 256 + lane * 4)); }
            }
#pragma unroll
            for (int rr = 0; rr < 4; ++rr) {
                const int row = row0 + rr;
                float ss = 0.f;
#pragma unroll
                for (int i = 0; i < 4; ++i) {
                    const f32x4 x = v[rr][i];
                    ss += x[0] * x[0] + x[1] * x[1] + x[2] * x[2] + x[3] * x[3];
                    st4bf(AX + (size_t)row * D + i * 256 + lane * 4, x);
                }
                ss = wave_sum(ss);
                if (lane < 16) RSQ[row * 16 + lane] = (lane == 0) ? ss : 0.f;
            }
        }
    }
    const int gt = bid * NTHR + tid, GT = G * NTHR;
    const int bt_lo = (part == 1) ? NPERM * 128 : 0, bt_hi = (part == 0) ? NPERM * 128 : 2 * NPERM * 128;
    for (int idx0 = bt_lo + gt; idx0 < bt_hi; idx0 += 4 * GT) {
        float v[4][8]; int nn[4];
#pragma unroll
        for (int u = 0; u < 4; ++u) {
            const int idx = idx0 + u * GT;
            nn[u] = -1;
#pragma unroll
            for (int e = 0; e < 8; ++e) v[u][e] = 0.f;
            if (idx < bt_hi) {
                const int np = idx % NPERM, k8 = ((idx / NPERM) & 127) * 8, l = idx / (NPERM * 128);
                nn[u] = perm_src(np);
                if (nn[u] >= 0) {
                    const float* W = p.in[7] + (size_t)l * D * NIN + nn[u];
#pragma unroll
                    for (int e = 0; e < 8; ++e) v[u][e] = __builtin_nontemporal_load(W + (size_t)(k8 + e) * NIN);
                }
            }
        }
#pragma unroll
        for (int u = 0; u < 4; ++u) {
            const int idx = idx0 + u * GT;
            if (idx < bt_hi) {
                const int np = idx % NPERM, k8 = ((idx / NPERM) & 127) * 8, l = idx / (NPERM * 128);
                const float* g = p.in[6] + l * D + k8;
                if (nn[u] <= -2) {
                    const int gc = -2 - nn[u];
                    const float* W = p.in[7] + (size_t)l * D * NIN + 2688; const float* w2 = p.in[10] + (size_t)l * 16 * 192 + gc;
                    for (int r = 0; r < 16; ++r) {
                        const float c = w2[r * 192];
#pragma unroll
                        for (int e = 0; e < 8; ++e) v[u][e] += W[(size_t)(k8 + e) * NIN + r] * c;
                    }
                }
                u32x4 w;
                w.x = cvt_pk(v[u][0] * g[0], v[u][1] * g[1]); w.y = cvt_pk(v[u][2] * g[2], v[u][3] * g[3]); w.z = cvt_pk(v[u][4] * g[4], v[u][5] * g[5]); w.w = cvt_pk(v[u][6] * g[6], v[u][7] * g[7]);
                *(u32x4*)((bf16_t*)(ws + O_BTIN) + ((size_t)l * NPERM + np) * D + k8) = w;
            }
        }
    }
    if (part != 0)
    for (int idx0 = gt; idx0 < 2 * 1024 * 128; idx0 += 4 * GT) {
        float v[4][8];
#pragma unroll
        for (int u = 0; u < 4; ++u) {
            const int idx = idx0 + u * GT;
#pragma unroll
            for (int e = 0; e < 8; ++e) v[u][e] = 0.f;
            if (idx < 2 * 1024 * 128) {
                const int d = idx & 1023, e8 = ((idx >> 10) & 127) * 8, l = idx >> 17;
                const float* W = p.in[23] + (size_t)l * D * D + d;
#pragma unroll
                for (int e = 0; e < 8; ++e) v[u][e] = __builtin_nontemporal_load(W + (size_t)(e8 + e) * D);
            }
        }
#pragma unroll
        for (int u = 0; u < 4; ++u) {
            const int idx = idx0 + u * GT;
            if (idx < 2 * 1024 * 128) {
                const int d = idx & 1023, e8 = ((idx >> 10) & 127) * 8, l = idx >> 17;
                u32x4 w; w.x = cvt_pk(v[u][0], v[u][1]); w.y = cvt_pk(v[u][2], v[u][3]); w.z = cvt_pk(v[u][4], v[u][5]); w.w = cvt_pk(v[u][6], v[u][7]);
                *(u32x4*)((bf16_t*)(ws + O_BTOUT) + ((size_t)l * D + d) * D + e8) = w;
            }
        }
    }
    if (part != 0)
    for (int idx = gt; idx < 2 * 256 * 32; idx += GT) {
        const int n = idx & 255, i8 = ((idx >> 8) & 31) * 8, l = idx >> 13;
        const float* W = p.in[21] + (size_t)l * 65536 + n;
        float v[8];
#pragma unroll
        for (int e = 0; e < 8; ++e) v[e] = W[(size_t)(i8 + e) * 256];
        u32x4 w; w.x = cvt_pk(v[0], v[1]); w.y = cvt_pk(v[2], v[3]); w.z = cvt_pk(v[4], v[5]); w.w = cvt_pk(v[6], v[7]);
        *(u32x4*)((bf16_t*)(ws + O_BTGLU) + ((size_t)l * 256 + n) * 256 + i8) = w;
    }
    if (part != 1)
    for (int idx = gt; idx < 384; idx += GT) {
        const float l0 = p.in[8][idx], l1 = p.in[8][384 + idx], m = fmaxf(l0, l1), e0 = expf(l0 - m), e1 = expf(l1 - m);
        float* LB = (float*)(ws + O_LB);
        LB[idx] = 0.f; LB[384 + idx] = e1 / (e0 + e1);
    }
}

namespace pg8 {
#define PG8_LAS __attribute__((address_space(3)))
typedef unsigned short bf16_t;
typedef short bf16x8 __attribute__((ext_vector_type(8)));
typedef float f32x4 __attribute__((ext_vector_type(4)));
typedef unsigned u32x4 __attribute__((ext_vector_type(4)));
constexpr int BM = 256, BK = 64, HALF = 128, HTB = HALF * BK * 2  , STAGE_BYTES = 8 * HTB, NXCD = 8, WGM = 8;

__host__ __device__ __forceinline__ int lds_byte(int r, int c) { const int st = (r >> 4) * 2 + (c >> 5), rr = r & 15, cc = c & 31, ob = rr * 64 + cc * 2; return st * 1024 + (ob ^ (((ob >> 9) & 1) << 5)); }
__host__ __device__ __forceinline__ void stage_rc(int b, int& R, int& C) { const int st = b / 1024, sb = b % 1024, swz = sb ^ (((sb >> 9) & 1) << 5); R = (st >> 1) * 16 + swz / 64; C = (st & 1) * 32 + (swz % 64) / 2; }
__host__ __device__ __forceinline__ int perm32(int rho) { const int n = rho >> 4, i = rho & 15; return 8 * (i >> 2) + 4 * n + (i & 3); }

struct Unit { int pm, pn; };
struct Gemm { const bf16_t* A; const bf16_t* Bt; int M, N, K; };

struct StaticOrder {
    int nM, nN, nwg, G, c;
    __host__ __device__ void init(int M, int N, int G_, int c_) { nM = M / BM; nN = N / BM; nwg = nM * nN; G = G_; c = c_; }
    __host__ __device__ bool next(int i, Unit& u) const {
        const long L = (long)i * G + c; if (L >= nwg) return false;
        int wgid = (int)L; { const int q = nwg / NXCD, r = nwg % NXCD, xcd = wgid % NXCD, off = wgid / NXCD; wgid = (xcd < r ? xcd * (q + 1) : r * (q + 1) + (xcd - r) * q) + off; }
        const int nig = WGM * nN, gid = wgid / nig, fm = gid * WGM, gsz = (nM - fm) < WGM ? (nM - fm) : WGM;
        u.pm = fm + ((wgid % nig) % gsz); u.pn = (wgid % nig) / gsz; return true;
    }
    __device__ __forceinline__ void a_ready(const Unit&) const {}
    __device__ __forceinline__ void done(const Unit&) const {}
};
template <class Epi, class Sched, bool STAMP = false>
__device__ __forceinline__ void gemm_phase(const int tid, PG8_LAS unsigned char* lds, const Gemm g, const Sched& S, const Epi& E, unsigned long long* stamps) {
    const int wid = __builtin_amdgcn_readfirstlane(tid >> 6), lane = tid & 63, wr = wid >> 2, wc = wid & 3, fr = lane & 15, fq = lane >> 4;
    const int K = g.K, nt = K / BK;
    int ts_lo = 0, ts_hi = 0, nts = 0; const unsigned long long rt_entry = STAMP ? (unsigned long long)wall_clock64() : 0ull;
#define PG8_STAMP() do { if (STAMP && wid == 0 && nts < 64) { const unsigned long long _c = (unsigned long long)clock64(); \
        ts_lo = (lane == nts) ? (int)(unsigned)_c : ts_lo; ts_hi = (lane == nts) ? (int)(unsigned)(_c >> 32) : ts_hi; ++nts; } } while (0)
    PG8_STAMP();
    unsigned voffA[2], voffB[2];
#pragma unroll
    for (int i = 0; i < 2; ++i) { int R, C; stage_rc(tid * 16 + i * 8192, R, C); const int Rb = Epi::PERM ? ((R & ~31) + perm32(R & 31)) : R;
        voffA[i] = (unsigned)(R * K + C) * 2u; voffB[i] = (unsigned)(Rb * K + C) * 2u; }
    const size_t kstep = (size_t)(BK * 2);
    const size_t hstep = (size_t)HALF * K * 2;
    const size_t tstep = 2 * hstep;
    const unsigned ldsw = (unsigned)wid * 1024u;
    const int aoff = lds_byte(wr * 64 + fr, fq * 8), boff = lds_byte(wc * 32 + fr, fq * 8);
#define PG8_SA(b, h) (((b) * 2 + (h)) * HTB)
#define PG8_SB(b, h) ((4 + (b) * 2 + (h)) * HTB)
#define PG8_STAGE(bufoff, gbase, voff) do { _Pragma("unroll") for (int _i = 0; _i < 2; ++_i) \
        __builtin_amdgcn_global_load_lds((const unsigned*)((const char*)(gbase) + (voff)[_i]), (PG8_LAS unsigned*)(lds + (bufoff) + ldsw + _i * 8192), 16, 0, 0); } while (0)
#define PG8_LDA(dst, b, h) do { _Pragma("unroll") for (int m = 0; m < 4; ++m) _Pragma("unroll") for (int k = 0; k < 2; ++k) dst[m][k] = *(const PG8_LAS bf16x8*)(lds + PG8_SA(b, h) + aoff + m * 2048 + k * 1024); } while (0)
#define PG8_LDB(dst, b, h) do { _Pragma("unroll") for (int n = 0; n < 2; ++n) _Pragma("unroll") for (int k = 0; k < 2; ++k) dst[n][k] = *(const PG8_LAS bf16x8*)(lds + PG8_SB(b, h) + boff + n * 2048 + k * 1024); } while (0)
#define PG8_MMA(ai, bj, At, Bt) do { __builtin_amdgcn_s_setprio(1); _Pragma("unroll") for (int m = 0; m < 4; ++m) _Pragma("unroll") for (int n = 0; n < 2; ++n) _Pragma("unroll") for (int k = 0; k < 2; ++k) \
        acc[ai][bj][m][n] = __builtin_amdgcn_mfma_f32_16x16x32_bf16(Bt[n][k], At[m][k], acc[ai][bj][m][n], 0, 0, 0); __builtin_amdgcn_s_setprio(0); } while (0)
#define PG8_WAIT_V(n) asm volatile("s_waitcnt vmcnt(" #n ")" ::: "memory")
#define PG8_WAIT_L(n) asm volatile("s_waitcnt lgkmcnt(" #n ")" ::: "memory")
#define PG8_BAR __builtin_amdgcn_s_barrier()
#define PG8_SCHED __builtin_amdgcn_sched_barrier(0)
    Unit cur, nxt; int ui = 0;
    if (!S.next(0, cur)) return;
    f32x4 acc[2][2][4][2];
#pragma unroll
    for (int a = 0; a < 2; ++a)
#pragma unroll
        for (int b = 0; b < 2; ++b)
#pragma unroll
            for (int m = 0; m < 4; ++m)
#pragma unroll
                for (int n = 0; n < 2; ++n) acc[a][b][m][n] = (f32x4){0.f, 0.f, 0.f, 0.f};
    bf16x8 At[4][2], B0[2][2], B1[2][2];
    const char* cA = (const char*)g.A + (size_t)cur.pm * tstep; const char* cB = (const char*)g.Bt + (size_t)cur.pn * tstep;
    S.a_ready(cur);
    PG8_STAGE(PG8_SB(0, 0), cB, voffB); PG8_STAGE(PG8_SA(0, 0), cA, voffA); PG8_STAGE(PG8_SB(0, 1), cB + hstep, voffB); PG8_STAGE(PG8_SA(0, 1), cA + hstep, voffA);
    if (wr == 1) PG8_BAR;
    PG8_WAIT_V(4); PG8_BAR;
    PG8_STAGE(PG8_SB(1, 0), cB + kstep, voffB); PG8_STAGE(PG8_SA(1, 0), cA + kstep, voffA); PG8_STAGE(PG8_SB(1, 1), cB + hstep + kstep, voffB);
    PG8_WAIT_V(6); PG8_BAR;
    PG8_STAMP();
    for (;;) {
        const bool has_next = S.next(ui + 1, nxt);
        const char* nA = has_next ? (const char*)g.A + (size_t)nxt.pm * tstep : cA; const char* nB = has_next ? (const char*)g.Bt + (size_t)nxt.pn * tstep : cB;
        for (int t = 0; t < nt; t += 2) {
            const bool last = (t == nt - 2);
            const char* a1 = cA + (size_t)(t + 1) * kstep;
            const char* a2 = last ? nA : cA + (size_t)(t + 2) * kstep; const char* b2 = last ? nB : cB + (size_t)(t + 2) * kstep;
            const char* a3 = a2 + kstep; const char* b3 = b2 + kstep;
            if (last && has_next) S.a_ready(nxt);
            PG8_LDB(B0, 0, 0); PG8_SCHED; PG8_LDA(At, 0, 0); PG8_STAGE(PG8_SA(1, 1), a1 + hstep, voffA);
            PG8_WAIT_L(8); PG8_BAR; PG8_WAIT_L(0); PG8_MMA(0, 0, At, B0); PG8_BAR; PG8_SCHED;
            PG8_LDB(B1, 0, 1); PG8_STAGE(PG8_SB(0, 0), b2, voffB);
            PG8_BAR; PG8_WAIT_L(0); PG8_MMA(0, 1, At, B1); PG8_BAR;
            PG8_LDA(At, 0, 1); PG8_STAGE(PG8_SA(0, 0), a2, voffA);
            PG8_BAR; PG8_WAIT_L(0); PG8_MMA(1, 0, At, B0); PG8_BAR; PG8_SCHED;
            PG8_STAGE(PG8_SB(0, 1), b2 + hstep, voffB);
            PG8_WAIT_V(6); PG8_BAR; PG8_MMA(1, 1, At, B1); PG8_BAR;
            PG8_LDB(B0, 1, 0); PG8_SCHED; PG8_LDA(At, 1, 0); PG8_STAGE(PG8_SA(0, 1), a2 + hstep, voffA);
            PG8_WAIT_L(8); PG8_BAR; PG8_WAIT_L(0); PG8_MMA(0, 0, At, B0); PG8_BAR; PG8_SCHED;
            PG8_LDB(B1, 1, 1); PG8_STAGE(PG8_SB(1, 0), b3, voffB);
            PG8_BAR; PG8_WAIT_L(0); PG8_MMA(0, 1, At, B1); PG8_BAR;
            PG8_LDA(At, 1, 1); PG8_STAGE(PG8_SA(1, 0), a3, voffA);
            PG8_BAR; PG8_WAIT_L(0); PG8_MMA(1, 0, At, B0); PG8_BAR; PG8_SCHED;
            PG8_STAGE(PG8_SB(1, 1), b3 + hstep, voffB);
            PG8_WAIT_V(6); PG8_BAR; PG8_MMA(1, 1, At, B1); PG8_BAR;
        }
        PG8_STAMP();
        if constexpr (!Epi::AFTER_DRAIN) { E(acc, cur, wr, wc, fr, fq); S.done(cur); }
        PG8_STAMP();
        if (!has_next) break;
#pragma unroll
        for (int a = 0; a < 2; ++a)
#pragma unroll
            for (int b = 0; b < 2; ++b)
#pragma unroll
                for (int m = 0; m < 4; ++m)
#pragma unroll
                    for (int n = 0; n < 2; ++n) acc[a][b][m][n] = (f32x4){0.f, 0.f, 0.f, 0.f};
        cur = nxt; cA = nA; cB = nB; ++ui;
    }
    PG8_WAIT_V(0);
    if (wr == 0) PG8_BAR;
    PG8_BAR;
    if constexpr (Epi::AFTER_DRAIN) { E.fused(acc, cur, wr, wc, fr, fq, lds, wid, lane); S.done(cur); }
    PG8_STAMP();
    if (STAMP && wid == 0) { stamps[lane] = lane < nts ? (((unsigned long long)(unsigned)ts_hi << 32) | (unsigned)ts_lo) : 0ull;
        if (lane == 62) stamps[62] = rt_entry; if (lane == 63) stamps[63] = (unsigned long long)wall_clock64(); }
#undef PG8_STAMP
#undef PG8_SA
#undef PG8_SB
#undef PG8_STAGE
#undef PG8_LDA
#undef PG8_LDB
#undef PG8_MMA
#undef PG8_WAIT_V
#undef PG8_WAIT_L
#undef PG8_BAR
#undef PG8_SCHED
}
}


DEV void inproj_store(const P& p, int l, int row, int ncol, f32x4 v, f32x4 lb) {
    unsigned char* ws = p.ws;
    const int pn = ncol >> 8, j = ncol & 255;
    if (pn < 6) {
        const int seg = j >> 6, c = pn * 64 + (j & 63);
        if (seg == 0) { st4bf((bf16_t*)(ws + O_HQ) + (size_t)row * 384 + c, (f32x4){siluf_(v[0]), siluf_(v[1]), siluf_(v[2]), siluf_(v[3])}); }
        else if (seg == 1) {
            f32x4 o;
#pragma unroll
            for (int r = 0; r < 4; ++r) o[r] = __logf(lb[r] + (1.0f - lb[r]) * sigmoidf_(v[r]));
            *(f32x4*)((float*)(ws + O_HG) + (size_t)row * 384 + c) = o;
        }
        else if (seg == 2) st4bf((bf16_t*)(ws + O_HV) + (size_t)row * 384 + c, v);
        else st4bf((bf16_t*)(ws + O_HZ) + (size_t)row * 384 + c, (f32x4){siluf_(v[0]), siluf_(v[1]), siluf_(v[2]), siluf_(v[3])});
    } else if (pn < 12) {
        const int h = pn - 6;
        if (j < 32) st4bf((bf16_t*)(ws + O_GQ) + (size_t)row * 384 + h * 64 + j, v * 0.17677669529663687f);
        else if (j < 64) st4bf((bf16_t*)(ws + O_GQ) + (size_t)row * 384 + h * 64 + j, v);
        else if (j < 128) st4bf((bf16_t*)(ws + O_GV) + (size_t)row * 384 + h * 64 + (j - 64), v);
        else if (j < 192) st4bf((bf16_t*)(ws + O_GZ) + (size_t)row * 384 + h * 64 + (j - 128), (f32x4){siluf_(v[0]), siluf_(v[1]), siluf_(v[2]), siluf_(v[3])});
        else if (j < 224) {
            f32x4 o;
#pragma unroll
            for (int r = 0; r < 4; ++r) { const float a = v[r] + lb[r]; o[r] = (fminf(a, 0.f) - __logf(1.0f + __expf(-fabsf(a)))) * (1.0f / 16.0f); }
            *(f32x4*)((float*)(ws + O_GR) + (size_t)row * 192 + h * 32 + (j - 192)) = o;
        }
    } else if (pn == 12) {
        if (row < TP) st4bf((bf16_t*)(ws + O_AS5) + ((size_t)(j >> 4) * 1024 + (row >> 4)) * 384 + (row & 15) * 16 + (j & 15), v);
        else if (row < MT) *(f32x4*)((float*)(ws + O_SUS) + (size_t)(row - TP) * 256 + j) = v;
    } else {
        st4bf((bf16_t*)(ws + O_SZ) + (size_t)row * 256 + j, (f32x4){siluf_(v[0]), siluf_(v[1]), siluf_(v[2]), siluf_(v[3])});
    }
}

DEV void st8bf(bf16_t* dst, f32x4 a, f32x4 b) { u32x4 w; w.x = cvt_pk(a[0], a[1]); w.y = cvt_pk(a[2], a[3]); w.z = cvt_pk(b[0], b[1]); w.w = cvt_pk(b[2], b[3]); *(u32x4*)dst = w; }
DEV f32x4 silu4(f32x4 v) { return (f32x4){siluf_(v[0]), siluf_(v[1]), siluf_(v[2]), siluf_(v[3])}; }

struct EpiIn {
    static constexpr bool PERM = true, AFTER_DRAIN = false;
    const P* p; int l;
    DEV void operator()(const f32x4 (&acc)[2][2][4][2], const pg8::Unit& u, int wr, int wc, int fr, int fq) const {
        unsigned char* ws = p->ws;
        const float* RSQ = (const float*)(ws + O_RSQ);
        const int pn = u.pn, rowb = u.pm * 256 + wr * 64 + fr;
float rr[2][4];
#pragma unroll
        for (int ai = 0; ai < 2; ++ai) {
            f32x4 q[4];
#pragma unroll
            for (int m = 0; m < 4; ++m) q[m] = *(const f32x4*)(RSQ + (rowb + ai * 128 + m * 16) * 16 + fq * 4);
#pragma unroll
            for (int m = 0; m < 4; ++m) {
                float ss = q[m][0] + q[m][1] + q[m][2] + q[m][3];
                ss += __shfl_xor(ss, 16); ss += __shfl_xor(ss, 32);
                rr[ai][m] = rsqrtf(ss * (1.0f / 1024.0f) + EPS);
            }
            asm volatile("" : "+v"(rr[ai][0]), "+v"(rr[ai][1]), "+v"(rr[ai][2]), "+v"(rr[ai][3]));
        }
#pragma unroll
        for (int ai = 0; ai < 2; ++ai) {
        float r[4];
#pragma unroll
        for (int m = 0; m < 4; ++m) r[m] = rr[ai][m];
#pragma unroll
        for (int bj = 0; bj < 2; ++bj) {
            const int j = bj * 128 + wc * 32 + 8 * fq;
            int kind; bf16_t* dstb = nullptr; float* dstf = nullptr; const float* exp_ = nullptr; int ld = 0;
            if (pn < 6) {
                const int seg = bj * 2 + (wc >> 1), c = pn * 64 + (j & 63); ld = 384;
                if (seg == 0) { kind = 1; dstb = (bf16_t*)(ws + O_HQ) + c; }
                else if (seg == 1) { kind = 2; dstf = (float*)(ws + O_HG) + c; exp_ = (const float*)(ws + O_LB) + l * 384 + c; }
                else if (seg == 2) { kind = 0; dstb = (bf16_t*)(ws + O_HV) + c; }
                else { kind = 1; dstb = (bf16_t*)(ws + O_HZ) + c; }
            } else if (pn < 12) {
                const int h = pn - 6; ld = 384;
                if (j < 32) { kind = 3; dstb = (bf16_t*)(ws + O_GQ) + h * 64 + j; }
                else if (j < 64) { kind = 0; dstb = (bf16_t*)(ws + O_GQ) + h * 64 + j; }
                else if (j < 128) { kind = 0; dstb = (bf16_t*)(ws + O_GV) + h * 64 + (j - 64); }
                else if (j < 192) { kind = 1; dstb = (bf16_t*)(ws + O_GZ) + h * 64 + (j - 128); }
                else if (j < 224) { kind = 4; dstf = (float*)(ws + O_GR) + h * 32 + (j - 192); ld = 192; exp_ = p->in[11] + l * 192 + h * 32 + (j - 192); }
                else kind = 6;
            } else if (pn == 12) { kind = 5; }
            else { kind = 1; dstb = (bf16_t*)(ws + O_SZ) + j; ld = 256; }
            f32x4 ex0 = (f32x4){0.f, 0.f, 0.f, 0.f}, ex1 = ex0;
            if (kind == 2 || kind == 4) { ex0 = *(const f32x4*)exp_; ex1 = *(const f32x4*)(exp_ + 4); }
#pragma unroll
                for (int m = 0; m < 4; ++m) {
                    const int row = rowb + ai * 128 + m * 16;
                    const f32x4 v0 = acc[ai][bj][m][0] * r[m], v1 = acc[ai][bj][m][1] * r[m];
                    if (kind == 0) st8bf(dstb + (size_t)row * ld, v0, v1);
                    else if (kind == 1) st8bf(dstb + (size_t)row * ld, silu4(v0), silu4(v1));
                    else if (kind == 3) st8bf(dstb + (size_t)row * ld, v0 * 0.17677669529663687f, v1 * 0.17677669529663687f);
                    else if (kind == 2) {
                        f32x4 o0, o1;
#pragma unroll
                        for (int e = 0; e < 4; ++e) { o0[e] = __logf(ex0[e] + (1.0f - ex0[e]) * sigmoidf_(v0[e])); o1[e] = __logf(ex1[e] + (1.0f - ex1[e]) * sigmoidf_(v1[e])); }
                        float* d = dstf + (size_t)row * ld; *(f32x4*)d = o0; *(f32x4*)(d + 4) = o1;
                    } else if (kind == 4) {
                        f32x4 o0, o1;
#pragma unroll
                        for (int e = 0; e < 4; ++e) {
                            const float a0 = v0[e] + ex0[e], a1 = v1[e] + ex1[e];
                            o0[e] = (fminf(a0, 0.f) - __logf(1.0f + __expf(-fabsf(a0)))) * (1.0f / 16.0f);
                            o1[e] = (fminf(a1, 0.f) - __logf(1.0f + __expf(-fabsf(a1)))) * (1.0f / 16.0f);
                        }
                        float* d = dstf + (size_t)row * ld; *(f32x4*)d = o0; *(f32x4*)(d + 4) = o1;
                    } else if (kind == 5) {
                        if (row < TP) st8bf((bf16_t*)(ws + O_AS5) + ((size_t)(j >> 4) * 1024 + (row >> 4)) * 384 + (row & 15) * 16 + (j & 15), v0, v1);
                        else if (row < MT) { float* d = (float*)(ws + O_SUS) + (size_t)(row - TP) * 256 + j; *(f32x4*)d = v0; *(f32x4*)(d + 4) = v1; }
                    }
                }
        }
        }
    }
};

DEV void phase_inproj(const Ctx cx, const P& p, int l, unsigned char* lds) {
    pg8::Gemm g{(const bf16_t*)(p.ws + O_AX), (const bf16_t*)(p.ws + O_BTIN) + (size_t)l * NPERM * D, MPAD, NPERM, D};
    pg8::StaticOrder S; S.init(MPAD, NPERM, cx.G, cx.bid);
    EpiIn E{&p, l};
    pg8::gemm_phase<EpiIn, pg8::StaticOrder>(cx.tid, (PG8_LAS unsigned char*)lds, g, S, E, nullptr);
    if (l == 0 && cx.G == 256 && cx.bid >= 142) phase_prep(cx, p, lds, 1, cx.bid - 142, 114);
}

template <int DK, int MODE>
DEV void chunk_item(const Ctx cx, const P& p, int l, int item, unsigned char* lds) {
    constexpr bool GLA = (DK == 32);
    constexpr int BSTR = DK + 4, KS = DK + 8, SS = 72, EPT = DK / 8;
    float* Bs = (float*)lds; float* Tot = Bs + 65 * BSTR; float* Rb = Tot + 16 * DK; float* W2s = Rb + 1024; float* b2s = W2s + 512; float* Psq = b2s + 32;
    bf16_t* Qh = (bf16_t*)(Psq + 128); bf16_t* Qt = Qh + 64 * KS; bf16_t* Kt = Qt + 64 * KS; bf16_t* ST = Kt + 4 * 64 * KS;
    bf16_t* VT = ST + 64 * KS; bf16_t* Att = VT + 64 * SS; bf16_t* KhT = Att + 64 * SS;
    const int tid = cx.tid, lane = tid & 63, wid = tid >> 6, fr = lane & 15, fq = lane >> 4;
    const int bh = item >> 5, c = item & 31, b = bh / 6, h = bh - b * 6, tok0 = b * 2048 + c * 64;
    unsigned char* ws = p.ws;
    bf16_t* DS = (bf16_t*)(ws + (GLA ? O_DSG : O_DSH)) + (size_t)item * 64 * DK;
#define NTL(T, ptr) __builtin_nontemporal_load((const T*)(ptr))
    const int t3 = tid >> 3, kp3 = tid & 7, k03 = kp3 * EPT; const size_t tok3 = (size_t)tok0 + t3;
    f32x4 pg0 = (f32x4){0.f, 0.f, 0.f, 0.f}, pg1 = pg0;
    u32x4 pq4 = (u32x4){0u, 0u, 0u, 0u}, pds4 = pq4; u32x2 pq2 = (u32x2){0u, 0u}, pk2 = pq2, pds2 = pq2;
    if (!GLA) {
        const float* g = (const float*)(ws + O_HG) + tok3 * 384 + h * 64 + kp3 * 8;
        pg0 = NTL(f32x4, g); pg1 = NTL(f32x4, g + 4);
        pq4 = NTL(u32x4, (const bf16_t*)(ws + O_HQ) + tok3 * 384 + h * 64 + k03);
        if (MODE == 1) pds4 = NTL(u32x4, DS + t3 * DK + k03);
    } else {
        pg0 = NTL(f32x4, (const float*)(ws + O_GR) + tok3 * 192 + h * 32 + kp3 * 4);
        pq2 = NTL(u32x2, (const bf16_t*)(ws + O_GQ) + tok3 * 384 + h * 64 + k03);
        pk2 = NTL(u32x2, (const bf16_t*)(ws + O_GQ) + tok3 * 384 + h * 64 + 32 + k03);
        if (MODE == 1) pds2 = NTL(u32x2, DS + t3 * DK + k03);
    }
    const u32x4 pvw = NTL(u32x4, (const bf16_t*)(ws + (GLA ? O_GV : O_HV)) + tok3 * 384 + h * 64 + kp3 * 8);
    f32x4 gnv[2] = {pg0, pg0}; u32x4 pz4 = pq4;
    if (MODE == 1) {
        const int I6 = wid & 3, vh6 = wid >> 2, t6 = 16 * I6 + fr;
#pragma unroll
        for (int ni = 0; ni < 2; ++ni) gnv[ni] = *(const f32x4*)(p.in[GLA ? 12 : 9] + l * 384 + h * 64 + vh6 * 32 + 8 * fq + 4 * ni);
        pz4 = NTL(u32x4, (const bf16_t*)(ws + (GLA ? O_GZ : O_HZ)) + ((size_t)tok0 + t6) * 384 + h * 64 + vh6 * 32 + 8 * fq);
    }
#undef NTL
    lds_barrier();
    if (!GLA) {
        *(f32x4*)(Bs + (t3 + 1) * BSTR + kp3 * 8) = pg0; *(f32x4*)(Bs + (t3 + 1) * BSTR + kp3 * 8 + 4) = pg1;
    } else {
        *(f32x4*)(Bs + (t3 + 1) * BSTR + kp3 * 4) = pg0;
    }
    if (tid < DK) Bs[tid] = 0.f;
    lds_barrier();
    {
        constexpr int NSEG = NTHR / DK, SEGLEN = 64 / NSEG;
        const int k = tid % DK, seg = tid / DK, t0 = seg * SEGLEN;
        float run = 0.f;
#pragma unroll
        for (int i = 0; i < SEGLEN; ++i) { run += Bs[(t0 + i + 1) * BSTR + k]; Bs[(t0 + i + 1) * BSTR + k] = run; }
        Tot[seg * DK + k] = run;
        lds_barrier();
        float off = 0.f;
        for (int s = 0; s < seg; ++s) off += Tot[s * DK + k];
#pragma unroll
        for (int i = 0; i < SEGLEN; ++i) Bs[(t0 + i + 1) * BSTR + k] += off;
    }
    lds_barrier();
    {
        const int t = tid >> 3, kp = tid & 7, k0 = kp * EPT, I = t >> 4;
        float qv[EPT], kv[EPT], bt[EPT];
#pragma unroll
        for (int e = 0; e < EPT; ++e) bt[e] = Bs[(t + 1) * BSTR + k0 + e];
        if (!GLA) {
            const u32x4 qw = pq4;
            qv[0] = bflo(qw.x); qv[1] = bfhi(qw.x); qv[2] = bflo(qw.y); qv[3] = bfhi(qw.y);
            if (EPT == 8) { qv[EPT - 4] = bflo(qw.z); qv[EPT - 3] = bfhi(qw.z); qv[EPT - 2] = bflo(qw.w); qv[EPT - 1] = bfhi(qw.w); }
#pragma unroll
            for (int e = 0; e < EPT; ++e) kv[e] = 1.0f - __expf(bt[e] - Bs[t * BSTR + k0 + e]);
        } else {
            const u32x2 qw = pq2, kw = pk2;
            qv[0] = bflo(qw.x); qv[1] = bfhi(qw.x); qv[2] = bflo(qw.y); qv[3] = bfhi(qw.y);
            kv[0] = bflo(kw.x); kv[1] = bfhi(kw.x); kv[2] = bflo(kw.y); kv[3] = bfhi(kw.y);
        }
        {
            const u32x4 vw = rot8h(pvw, kp);
            const unsigned w4[4] = {vw.x, vw.y, vw.z, vw.w};
#pragma unroll
            for (int i = 0; i < 8; ++i) { const int vv = kp * 8 + ((i + kp) & 7); VT[(MODE == 1 ? vslot(vv) : vv) * SS + t] = (bf16_t)((i & 1) ? (w4[i >> 1] >> 16) : (w4[i >> 1] & 0xffffu)); }
        }
        if (MODE == 0) {
#pragma unroll
            for (int e = 0; e < EPT; ++e) kv[e] *= __expf(Bs[64 * BSTR + k0 + e] - bt[e]);
            if (EPT == 8) {
                u32x4 kw8; kw8.x = cvt_pk(kv[0], kv[1]); kw8.y = cvt_pk(kv[2], kv[3]); kw8.z = cvt_pk(kv[EPT - 4], kv[EPT - 3]); kw8.w = cvt_pk(kv[EPT - 2], kv[EPT - 1]);
                kw8 = rot8h(kw8, kp);
                const unsigned w4[4] = {kw8.x, kw8.y, kw8.z, kw8.w};
#pragma unroll
                for (int i = 0; i < 8; ++i) KhT[(kp * 8 + ((i + kp) & 7)) * SS + t] = (bf16_t)((i & 1) ? (w4[i >> 1] >> 16) : (w4[i >> 1] & 0xffffu));
            } else {
                u32x2 kw4; kw4.x = cvt_pk(kv[0], kv[1]); kw4.y = cvt_pk(kv[2], kv[3]);
                const int rr = kp >> 1;
                kw4 = rot4h(kw4, rr);
                const unsigned w2[2] = {kw4.x, kw4.y};
#pragma unroll
                for (int i = 0; i < 4; ++i) KhT[(kp * 4 + ((i + rr) & 3)) * SS + t] = (bf16_t)((i & 1) ? (w2[i >> 1] >> 16) : (w2[i >> 1] & 0xffffu));
            }
            if (tid < DK) ((float*)(ws + (GLA ? O_DDG : O_DDH)))[(size_t)item * DK + tid] = __expf(Bs[64 * BSTR + tid]);
        } else {
            float o1[EPT], o2[EPT];
#pragma unroll
            for (int e = 0; e < EPT; ++e) { o1[e] = qv[e] * __expf(bt[e]); o2[e] = qv[e] * __expf(bt[e] - Bs[(16 * I) * BSTR + k0 + e]); }
#pragma unroll
            for (int e = 0; e < EPT; e += 4) { st4bf(Qh + t * KS + k0 + e, (f32x4){o1[e], o1[e + 1], o1[e + 2], o1[e + 3]}); st4bf(Qt + t * KS + k0 + e, (f32x4){o2[e], o2[e + 1], o2[e + 2], o2[e + 3]}); }
            for (int I2 = I; I2 < 4; ++I2) {
#pragma unroll
                for (int e = 0; e < EPT; ++e) o1[e] = kv[e] * expc(Bs[(16 * I2) * BSTR + k0 + e] - bt[e]);
#pragma unroll
                for (int e = 0; e < EPT; e += 4) st4bf(Kt + (I2 * 64 + t) * KS + k0 + e, (f32x4){o1[e], o1[e + 1], o1[e + 2], o1[e + 3]});
            }
            if (EPT == 8) *(u32x4*)(ST + vslot(t) * KS + k0) = pds4;
            else *(u32x2*)(ST + vslot(t) * KS + k0) = pds2;
        }
    }
    lds_barrier();
    if (MODE == 0) {
        const int mi = wid & 3;
#pragma unroll
        for (int x = 0; x < DK / 32; ++x) {
            const int nj = (wid >> 2) * (DK / 32) + x;
            f32x4 acc = (f32x4){0.f, 0.f, 0.f, 0.f};
#pragma unroll
            for (int kk = 0; kk < 2; ++kk) {
                const bf16x8 a = *(const bf16x8*)(VT + (16 * mi + fr) * SS + kk * 32 + fq * 8);
                const bf16x8 bq = *(const bf16x8*)(KhT + (16 * nj + fr) * SS + kk * 32 + fq * 8);
                acc = __builtin_amdgcn_mfma_f32_16x16x32_bf16(bq, a, acc, 0, 0, 0);
            }
            st4bf(DS + (16 * mi + fr) * DK + 16 * nj + 4 * fq, acc);
        }
        return;
    }
#pragma unroll
    for (int rep = 0; rep < 2; ++rep) {
        const int idx = wid + rep * 8;
        if (idx < 10) {
            const int I = idx >= 6 ? 3 : (idx >= 3 ? 2 : (idx >= 1 ? 1 : 0)), J = idx - (I * (I + 1)) / 2;
            f32x4 acc = (f32x4){0.f, 0.f, 0.f, 0.f};
#pragma unroll
            for (int kk = 0; kk < DK / 32; ++kk) {
                const bf16x8 a = *(const bf16x8*)(Qt + (16 * I + fr) * KS + kk * 32 + fq * 8);
                const bf16x8 bq = *(const bf16x8*)(Kt + (I * 64 + 16 * J + fr) * KS + kk * 32 + fq * 8);
                acc = __builtin_amdgcn_mfma_f32_16x16x32_bf16(bq, a, acc, 0, 0, 0);
            }
            if (I == J) {
#pragma unroll
                for (int r = 0; r < 4; ++r) if (4 * fq + r > fr) acc[r] = 0.f;
            }
            st4bf(Att + (16 * I + fr) * SS + 16 * J + 4 * fq, acc);
        } else {
            const int z = idx - 10, I = z < 3 ? 0 : (z < 5 ? 1 : 2), J = z < 3 ? z + 1 : (z < 5 ? z - 1 : 3);
            *(u32x2*)(Att + (16 * I + fr) * SS + 16 * J + 4 * fq) = (u32x2){0u, 0u};
        }
    }
    lds_barrier();
    const int I = wid & 3, vh = wid >> 2;
    f32x4 o[2];
#pragma unroll
    for (int ni = 0; ni < 2; ++ni) {
        f32x4 acc = (f32x4){0.f, 0.f, 0.f, 0.f};
#pragma unroll
        for (int kk = 0; kk < DK / 32; ++kk) {
            const bf16x8 a = *(const bf16x8*)(Qh + (16 * I + fr) * KS + kk * 32 + fq * 8);
            const bf16x8 bq = *(const bf16x8*)(ST + (vh * 32 + ni * 16 + fr) * KS + kk * 32 + fq * 8);
            acc = __builtin_amdgcn_mfma_f32_16x16x32_bf16(bq, a, acc, 0, 0, 0);
        }
#pragma unroll
        for (int kk = 0; kk < 2; ++kk) {
            const bf16x8 a = *(const bf16x8*)(Att + (16 * I + fr) * SS + kk * 32 + fq * 8);
            const bf16x8 bq = *(const bf16x8*)(VT + (vh * 32 + ni * 16 + fr) * SS + kk * 32 + fq * 8);
            acc = __builtin_amdgcn_mfma_f32_16x16x32_bf16(bq, a, acc, 0, 0, 0);
        }
        o[ni] = acc;
    }
    float ss = 0.f;
#pragma unroll
    for (int ni = 0; ni < 2; ++ni) ss += o[ni][0] * o[ni][0] + o[ni][1] * o[ni][1] + o[ni][2] * o[ni][2] + o[ni][3] * o[ni][3];
    ss += __shfl_xor(ss, 16); ss += __shfl_xor(ss, 32);
    const int t = 16 * I + fr;
    if (fq == 0) Psq[t * 2 + vh] = ss;
    lds_barrier();
    const float sc = rsqrtf((Psq[t * 2] + Psq[t * 2 + 1]) * (1.0f / 64.0f) + EPS);
    bf16_t* MIX = (bf16_t*)(ws + O_MIX) + ((size_t)tok0 + t) * 1024 + (GLA ? 384 : 0) + h * 64;
    {
        const int v0 = vh * 32 + 8 * fq;
        const f32x4 g0 = gnv[0], g1 = gnv[1]; const u32x4 zw = pz4;
        u32x4 w;
        w.x = cvt_pk(o[0][0] * sc * g0[0] * bflo(zw.x), o[0][1] * sc * g0[1] * bfhi(zw.x)); w.y = cvt_pk(o[0][2] * sc * g0[2] * bflo(zw.y), o[0][3] * sc * g0[3] * bfhi(zw.y));
        w.z = cvt_pk(o[1][0] * sc * g1[0] * bflo(zw.z), o[1][1] * sc * g1[1] * bfhi(zw.z)); w.w = cvt_pk(o[1][2] * sc * g1[2] * bflo(zw.w), o[1][3] * sc * g1[3] * bfhi(zw.w));
        *(u32x4*)(MIX + v0) = w;
    }
}

template <int DK>
DEV void chunk_item0(const Ctx cx, const P& p, int l, int item, unsigned char* lds) {
    constexpr bool GLA = (DK == 32);
    constexpr int SS = 72, NSEG = NTHR / DK, SL = 64 / NSEG;
    float* Tot = (float*)lds;
    bf16_t* VT = (bf16_t*)(Tot + NSEG * DK);
    bf16_t* KhT = VT + 64 * SS;
    const int tid = cx.tid, lane = tid & 63, wid = tid >> 6, fr = lane & 15, fq = lane >> 4;
    const int bh = item >> 5, c = item & 31, b = bh / 6, h = bh - b * 6, tok0 = b * 2048 + c * 64;
    unsigned char* ws = p.ws;
    bf16_t* DS = (bf16_t*)(ws + (GLA ? O_DSG : O_DSH)) + (size_t)item * 64 * DK;
    const int k = tid % DK, seg = tid / DK, t0 = seg * SL;
    float g[SL]; bf16_t kr[SL];
#pragma unroll
    for (int i = 0; i < SL; ++i) {
        const size_t tok = (size_t)tok0 + t0 + i;
        if (!GLA) g[i] = ((const float*)(ws + O_HG))[tok * 384 + h * 64 + k];
        else { g[i] = ((const float*)(ws + O_GR))[tok * 192 + h * 32 + k]; kr[i] = ((const bf16_t*)(ws + O_GQ))[tok * 384 + h * 64 + 32 + k]; }
    }
    const int v = tid & 63, vs = tid >> 6;
    bf16_t vr[8];
#pragma unroll
    for (int i = 0; i < 8; ++i) vr[i] = ((const bf16_t*)(ws + (GLA ? O_GV : O_HV)))[((size_t)tok0 + vs * 8 + i) * 384 + h * 64 + v];
    float bt[SL]; float run = 0.f;
#pragma unroll
    for (int i = 0; i < SL; ++i) { run += g[i]; bt[i] = run; }
    lds_barrier();
    Tot[seg * DK + k] = run;
    { u32x4 w; w.x = (unsigned)vr[0] | ((unsigned)vr[1] << 16); w.y = (unsigned)vr[2] | ((unsigned)vr[3] << 16); w.z = (unsigned)vr[4] | ((unsigned)vr[5] << 16); w.w = (unsigned)vr[6] | ((unsigned)vr[7] << 16);
      *(u32x4*)(VT + v * SS + vs * 8) = w; }
    lds_barrier();
    float off = 0.f, tot = 0.f;
#pragma unroll
    for (int s2 = 0; s2 < NSEG; ++s2) { const float x = Tot[s2 * DK + k]; tot += x; if (s2 < seg) off += x; }
    float kh[SL];
#pragma unroll
    for (int i = 0; i < SL; ++i) {
        const float kv = GLA ? bf2f(kr[i]) : 1.0f - __expf(g[i]);
        kh[i] = kv * __expf(tot - (bt[i] + off));
    }
    if (SL == 8) { u32x4 w; w.x = cvt_pk(kh[0], kh[1]); w.y = cvt_pk(kh[2], kh[3]); w.z = cvt_pk(kh[SL - 4], kh[SL - 3]); w.w = cvt_pk(kh[SL - 2], kh[SL - 1]); *(u32x4*)(KhT + k * SS + t0) = w; }
    else { u32x2 w; w.x = cvt_pk(kh[0], kh[1]); w.y = cvt_pk(kh[2], kh[3]); *(u32x2*)(KhT + k * SS + t0) = w; }
    if (seg == 0) ((float*)(ws + (GLA ? O_DDG : O_DDH)))[(size_t)item * DK + k] = __expf(tot);
    lds_barrier();
    const int mi = wid & 3;
#pragma unroll
    for (int x = 0; x < DK / 32; ++x) {
        const int nj = (wid >> 2) * (DK / 32) + x;
        f32x4 acc = (f32x4){0.f, 0.f, 0.f, 0.f};
#pragma unroll
        for (int kk = 0; kk < 2; ++kk) {
            const bf16x8 a = *(const bf16x8*)(VT + (16 * mi + fr) * SS + kk * 32 + fq * 8);
            const bf16x8 bq = *(const bf16x8*)(KhT + (16 * nj + fr) * SS + kk * 32 + fq * 8);
            acc = __builtin_amdgcn_mfma_f32_16x16x32_bf16(bq, a, acc, 0, 0, 0);
        }
        st4bf(DS + (16 * mi + fr) * DK + 16 * nj + 4 * fq, acc);
    }
}

DEV void phase_b1(const Ctx cx0, const P& p, int l, unsigned char* lds) {
    for (int it = cx0.bid; it < 3200; it += cx0.G) {
        const Ctx cx = relaunder(cx0);
        const int tid = cx.tid, lane = tid & 63, wid = tid >> 6, wr = wid >> 1, wc = wid & 1, fr = lane & 15, fq = lane >> 4;
#ifndef B1MASK
#define B1MASK 7
#endif
        if (it < 1536) { if (B1MASK & 1) chunk_item0<64>(cx, p, l, it, lds); }
        else if (it < 3072) { if (B1MASK & 2) chunk_item0<32>(cx, p, l, it - 1536, lds); }
        else if (B1MASK & 4) {
            const int it0 = it - 3072, it2 = (cx.G == 256) ? (((it0 & 7) << 4) | (it0 >> 3)) : it0;
            const int g = it2 >> 3, rt = it2 & 7;
            f32x4 acc[2][4];
            gemm128<2>(cx, (const bf16_t*)(p.ws + O_AS5) + (size_t)g * 1024 * 384, 384, (const bf16_t*)(p.ws + O_BTS5S) + (size_t)(l * 16 + g) * 128 * 256, 256, rt * 128, 0, lds, acc);
            float* S5S = (float*)(p.ws + O_S5S);
#pragma unroll
            for (int mi = 0; mi < 2; ++mi)
#pragma unroll
                for (int ni = 0; ni < 4; ++ni) {
                    const int ch = rt * 128 + wr * 32 + mi * 16 + fr, n = wc * 64 + ni * 16 + 4 * fq;
                    *(f32x4*)(S5S + ((size_t)g * 1024 + ch) * 128 + n) = acc[mi][ni];
                }
        }
    }
}

DEV void glu_tile(const Ctx cx, const P& p, int l, const bf16_t* Y, int rowbase, int rt, int ct, unsigned char* lds);
DEV void phase_b3(const Ctx cx0, const P& p, int l, unsigned char* lds) {
    const bool rebal = (cx0.G == 256);
    if (rebal && cx0.bid >= 2 && cx0.bid < 6) {
        const Ctx cx = relaunder(cx0);
        const int e = cx0.bid - 2, it = (e & 1) + 256 * (10 + (e >> 1));
        chunk_item<32, 1>(cx, p, l, it - 1536, lds);
    }
    for (int it = cx0.bid; it < 3330; it += cx0.G) {
        if (rebal && cx0.bid < 2 && it >= 2560 && it < 3072) continue;
        const Ctx cx = relaunder(cx0);
        const int tid = cx.tid, lane = tid & 63, wid = tid >> 6, wr = wid >> 1, wc = wid & 1, fr = lane & 15, fq = lane >> 4;
        if (it >= 3328) { glu_tile(cx, p, l, (const bf16_t*)(p.ws + O_YGS), TP, 0, it - 3328, lds); continue; }
        if (it < 1536) chunk_item<64, 1>(cx, p, l, it, lds);
        else if (it < 3072) chunk_item<32, 1>(cx, p, l, it - 1536, lds);
        else {
            const int it0 = it - 3072, it2 = (cx.G == 256) ? (((it0 & 7) << 5) | (it0 >> 3)) : it0;
            const int g = it2 >> 4, rt = (it2 & 15) >> 1, ct = it2 & 1;
            f32x4 acc[2][4];
            gemm128<3>(cx, (const bf16_t*)(p.ws + O_AS5) + (size_t)g * 1024 * 384, 384, (const bf16_t*)(p.ws + O_BTS5Y) + (size_t)(l * 16 + g) * 256 * 384, 384, rt * 128, ct * 128, lds, acc);
            bf16_t* YG = (bf16_t*)(p.ws + O_S5S);
#pragma unroll
            for (int mi = 0; mi < 2; ++mi)
#pragma unroll
                for (int ni = 0; ni < 4; ++ni) {
                    const int ch = rt * 128 + wr * 32 + mi * 16 + fr, n = ct * 128 + wc * 64 + ni * 16 + 4 * fq, i = n >> 4, c = n & 15;
                    const f32x4 a = acc[mi][ni];
                    st4bf(YG + ((size_t)ch * 16 + i) * 256 + g * 16 + c, (f32x4){geluf_(a[0]), geluf_(a[1]), geluf_(a[2]), geluf_(a[3])});
                }
        }
    }
}

DEV void outproj_tile128(const Ctx cx, const P& p, int l, int ct, int kc, unsigned char* lds);
DEV void glu_tile(const Ctx cx, const P& p, int l, const bf16_t* Y, int rowbase, int rt, int ct, unsigned char* lds) {
    const int tid = cx.tid, lane = tid & 63, wid = tid >> 6, wr = wid >> 1, wc = wid & 1, fr = lane & 15, fq = lane >> 4;
    f32x4 bg[4]; u32x2 yw[2][4], zw[2][4];
#pragma unroll
    for (int ni = 0; ni < 4; ++ni) bg[ni] = *(const f32x4*)(p.in[22] + l * 256 + ct * 128 + wc * 64 + ni * 16 + 4 * fq);
#pragma unroll
    for (int mi = 0; mi < 2; ++mi)
#pragma unroll
        for (int ni = 0; ni < 4; ++ni) {
            const int yr = rt * 128 + wr * 32 + mi * 16 + fr, n = ct * 128 + wc * 64 + ni * 16 + 4 * fq;
            yw[mi][ni] = __builtin_nontemporal_load((const u32x2*)(Y + (size_t)yr * 256 + n));
            zw[mi][ni] = __builtin_nontemporal_load((const u32x2*)((const bf16_t*)(p.ws + O_SZ) + ((size_t)rowbase + yr) * 256 + n));
        }
    f32x4 acc[2][4];
    gemm128<2>(cx, Y, 256, (const bf16_t*)(p.ws + O_BTGLU) + (size_t)l * 65536, 256, rt * 128, ct * 128, lds, acc);
#pragma unroll
    for (int mi = 0; mi < 2; ++mi)
#pragma unroll
        for (int ni = 0; ni < 4; ++ni) {
            const int yr = rt * 128 + wr * 32 + mi * 16 + fr, n = ct * 128 + wc * 64 + ni * 16 + 4 * fq; const size_t tok = (size_t)rowbase + yr;
            const f32x4 a = acc[mi][ni] + bg[ni];
            const u32x2 y2 = yw[mi][ni], z2 = zw[mi][ni];
            f32x4 r; r[0] = bflo(y2.x) * sigmoidf_(a[0]) * bflo(z2.x); r[1] = bfhi(y2.x) * sigmoidf_(a[1]) * bfhi(z2.x);
            r[2] = bflo(y2.y) * sigmoidf_(a[2]) * bflo(z2.y); r[3] = bfhi(y2.y) * sigmoidf_(a[3]) * bfhi(z2.y);
            st4bf((bf16_t*)(p.ws + O_MIX) + tok * 1024 + 768 + n, r);
        }
}

DEV void phase_b4(const Ctx cx0, const P& p, int l, unsigned char* lds) {
    for (int it = cx0.bid; it < 288; it += cx0.G) {
        const Ctx cx = relaunder(cx0);
        if (it >= 256) outproj_tile128(cx, p, l, (it - 256) & 7, (it - 256) >> 3, lds);
        else { const int is = (cx0.G == 256) ? (((it & 7) << 5) | (it >> 3)) : it; glu_tile(cx, p, l, (const bf16_t*)(p.ws + O_S5S), 0, is >> 1, is & 1, lds); }
    }
}

template <int DK>
DEV void scan_item(const Ctx cx, const P& p, int l, int wi) {
    constexpr bool GLA = (DK == 32);
    constexpr int WPB = (64 * DK) / 256;
    const int lane = cx.tid & 63;
    const int bh = wi / WPB, sub = wi - bh * WPB, e0 = sub * 256 + lane * 4, v = e0 / DK, k = e0 % DK;
    const float* DD = (const float*)(p.ws + (GLA ? O_DDG : O_DDH)) + (size_t)bh * 32 * DK + k;
    bf16_t* DS = (bf16_t*)(p.ws + (GLA ? O_DSG : O_DSH)) + (size_t)bh * 32 * 64 * DK + e0;
    f32x4 S = (f32x4){0.f, 0.f, 0.f, 0.f};
    for (int c0 = 0; c0 < 32; c0 += 16) {
        f32x4 d[16]; u32x2 w[16];
#pragma unroll
        for (int i = 0; i < 16; ++i) { d[i] = __builtin_nontemporal_load((const f32x4*)(DD + (size_t)(c0 + i) * DK)); w[i] = *(const u32x2*)(DS + (size_t)(c0 + i) * 64 * DK); }
#pragma unroll
        for (int i = 0; i < 16; ++i) {
            st4bf(DS + (size_t)(c0 + i) * 64 * DK, S);
            S[0] = d[i][0] * S[0] + bflo(w[i].x); S[1] = d[i][1] * S[1] + bfhi(w[i].x); S[2] = d[i][2] * S[2] + bflo(w[i].y); S[3] = d[i][3] * S[3] + bfhi(w[i].y);
        }
    }
    float* o = p.out + (GLA ? OUT_GP : OUT_HP) + ((size_t)l * 48 + bh) * DK * 64;
#pragma unroll
    for (int e = 0; e < 4; ++e) o[(k + e) * 64 + v] = S[e];
}

DEV void s5_scan_item(const Ctx cx, const P& p, int l, int wi) {
    const int lane = cx.tid & 63, b = wi >> 4, g = wi & 15;
    const float* A16 = (const float*)(p.ws + O_A16) + ((l * 16 + g) * 64 + lane) * 2;
    const float ar = A16[0], ai = A16[1];
    const float* S5S = (const float*)(p.ws + O_S5S) + ((size_t)g * 1024 + b * 128) * 128 + lane;
    bf16_t* AS5 = (bf16_t*)(p.ws + O_AS5) + ((size_t)g * 1024 + b * 128) * 384 + 256 + lane;
    float xr = 0.f, xi = 0.f;
    float sr[16], si[16], tr[16], ti[16];
#pragma unroll
    for (int i = 0; i < 16; ++i) { sr[i] = __builtin_nontemporal_load(S5S + i * 128); si[i] = __builtin_nontemporal_load(S5S + i * 128 + 64); }
    for (int c0 = 0; c0 < 128; c0 += 16) {
        if (c0 + 16 < 128) {
#pragma unroll
            for (int i = 0; i < 16; ++i) { tr[i] = __builtin_nontemporal_load(S5S + (c0 + 16 + i) * 128); ti[i] = __builtin_nontemporal_load(S5S + (c0 + 16 + i) * 128 + 64); }
        }
#pragma unroll
        for (int i = 0; i < 16; ++i) {
            AS5[(size_t)(c0 + i) * 384] = f2bf(xr); AS5[(size_t)(c0 + i) * 384 + 64] = f2bf(xi);
            const float nr = ar * xr - ai * xi + sr[i], ni = ar * xi + ai * xr + si[i];
            xr = nr; xi = ni;
        }
#pragma unroll
        for (int i = 0; i < 16; ++i) { sr[i] = tr[i]; si[i] = ti[i]; }
    }
    p.out[OUT_RP + ((size_t)(l * 8 + b) * 16 + g) * 64 + lane] = xr;
    p.out[OUT_IP + ((size_t)(l * 8 + b) * 16 + g) * 64 + lane] = xi;
}

template <int DK>
DEV void sample_rec_item(const Ctx cx, const P& p, int l, int wi) {
    constexpr bool GLA = (DK == 32);
    const int lane = cx.tid & 63, j = wi / 6, h = wi - j * 6; const size_t row = TP + j;
    unsigned char* ws = p.ws;
    float fk, kk_, qk;
    if (!GLA) {
        const float g = ((const float*)(ws + O_HG))[row * 384 + h * 64 + lane];
        fk = __expf(g); kk_ = 1.0f - fk; qk = bf2f(((const bf16_t*)(ws + O_HQ))[row * 384 + h * 64 + lane]);
    } else {
        const int k = lane & 31;
        fk = __expf(((const float*)(ws + O_GR))[row * 192 + h * 32 + k]);
        kk_ = bf2f(((const bf16_t*)(ws + O_GQ))[row * 384 + h * 64 + 32 + k]); qk = bf2f(((const bf16_t*)(ws + O_GQ))[row * 384 + h * 64 + k]);
    }
    const float vv = bf2f(((const bf16_t*)(ws + (GLA ? O_GV : O_HV)))[row * 384 + h * 64 + lane]);
    const float* S0 = p.in[GLA ? 3 : 2] + (((size_t)l * 128 + j) * 6 + h) * DK * 64;
    float* S1 = p.out + (GLA ? OUT_GS : OUT_HS) + (((size_t)l * 128 + j) * 6 + h) * DK * 64;
    float o = 0.f;
    const float gn = p.in[GLA ? 12 : 9][l * 384 + h * 64 + lane];
    const float z = bf2f(((const bf16_t*)(ws + (GLA ? O_GZ : O_HZ)))[row * 384 + h * 64 + lane]);
    for (int k0 = 0; k0 < DK; k0 += 16) {
        float s0[16];
#pragma unroll
        for (int i = 0; i < 16; ++i) s0[i] = __builtin_nontemporal_load(S0 + (k0 + i) * 64 + lane);
#pragma unroll
        for (int i = 0; i < 16; ++i) {
            const int k = k0 + i;
            const float f = __shfl(fk, k), kq = __shfl(kk_, k), qq = __shfl(qk, k);
            const float sn = f * s0[i] + kq * vv;
            S1[k * 64 + lane] = sn; o += qq * sn;
        }
    }
    const float ss = wave_sum(o * o), sc = rsqrtf(ss * (1.0f / 64.0f) + EPS);
    ((bf16_t*)(ws + O_MIX))[row * 1024 + (GLA ? 384 : 0) + h * 64 + lane] = f2bf(o * sc * gn * z);
}

DEV void sample_s5_item(const Ctx cx, const P& p, int l, int wi) {
    const int lane = cx.tid & 63, j = wi >> 4, g = wi & 15, lg = l * 16 + g;
    unsigned char* ws = p.ws;
    const float* u = (const float*)(ws + O_SUS) + (size_t)j * 256 + g * 16;
    const float* AB = (const float*)(ws + O_ABAR) + (lg * 64 + lane) * 2;
    const float* BB = (const float*)(ws + O_BB) + ((size_t)(lg * 64 + lane) * 16) * 2;
    const size_t so = (((size_t)l * 128 + j) * 16 + g) * 64 + lane;
    const float x0r = p.in[4][so], x0i = p.in[5][so];
    float cr[16], ci[16];
#pragma unroll
    for (int c = 0; c < 16; ++c) { cr[c] = p.in[17][((size_t)lg * 16 + c) * 64 + lane]; ci[c] = p.in[18][((size_t)lg * 16 + c) * 64 + lane]; }
    float xr = AB[0] * x0r - AB[1] * x0i, xi = AB[0] * x0i + AB[1] * x0r;
#pragma unroll
    for (int c = 0; c < 16; ++c) { const float uu = u[c]; xr += BB[c * 2] * uu; xi += BB[c * 2 + 1] * uu; }
    const float du = (lane < 16) ? p.in[19][l * 256 + g * 16 + lane] * u[lane] : 0.f;
    p.out[OUT_RS + so] = xr; p.out[OUT_IS + so] = xi;
    float mine = 0.f;
#pragma unroll
    for (int c = 0; c < 16; ++c) {
        const float part = wave_sum(cr[c] * xr - ci[c] * xi);
        if (lane == c) mine = part;
    }
    if (lane < 16) {
        const float y = mine + du;
        ((bf16_t*)(ws + O_YGS))[(size_t)j * 256 + g * 16 + lane] = f2bf(geluf_(y));
    }
}

DEV void phase_b2(const Ctx cx, const P& p, int l, unsigned char* lds) {
    const int wid = cx.tid >> 6;
    if (cx.G >= 256) {
        if (wid == 0 && cx.bid < 128) { s5_scan_item(cx, p, l, cx.bid); return; }
        const int rank = (wid == 0) ? cx.bid - 128 : 128 + (wid - 1) * cx.G + cx.bid, nw = cx.G * 8 - 128;
        for (int it = 128 + rank; it < 4864; it += nw) {
            if (it < 896) scan_item<64>(cx, p, l, it - 128);
            else if (it < 1280) scan_item<32>(cx, p, l, it - 896);
            else if (it < 2048) sample_rec_item<64>(cx, p, l, it - 1280);
            else if (it < 2816) sample_rec_item<32>(cx, p, l, it - 2048);
            else sample_s5_item(cx, p, l, it - 2816);
        }
        return;
    }
    const int TW = cx.G * 8;
    for (int it = cx.bid + cx.G * wid; it < 4864; it += TW) {
        if (it < 128) s5_scan_item(cx, p, l, it);
        else if (it < 896) scan_item<64>(cx, p, l, it - 128);
        else if (it < 1280) scan_item<32>(cx, p, l, it - 896);
        else if (it < 2048) sample_rec_item<64>(cx, p, l, it - 1280);
        else if (it < 2816) sample_rec_item<32>(cx, p, l, it - 2048);
        else sample_s5_item(cx, p, l, it - 2816);
    }
}

DEV void outproj_tile128(const Ctx cx, const P& p, int l, int ct, int kc, unsigned char* lds) {
    const int tid = cx.tid, lane = tid & 63, wid = tid >> 6, wr = wid >> 1, wc = wid & 1, fr = lane & 15, fq = lane >> 4;
    const bf16_t* MIX = (const bf16_t*)(p.ws + O_MIX) + kc * 256;
    const bf16_t* Bt = (const bf16_t*)(p.ws + O_BTOUT) + (size_t)l * D * D + kc * 256;
    float* PART = (float*)(p.ws + O_PART) + (size_t)kc * 128 * D;
    f32x4 acc[2][4];
    gemm128<2>(cx, MIX, D, Bt, D, TP, ct * 128, lds, acc);
#pragma unroll
    for (int mi = 0; mi < 2; ++mi)
#pragma unroll
        for (int ni = 0; ni < 4; ++ni)
            *(f32x4*)(PART + (size_t)(wr * 32 + mi * 16 + fr) * D + ct * 128 + wc * 64 + ni * 16 + 4 * fq) = acc[mi][ni];
}

DEV void sample_finalize(const Ctx cx, const P& p, int j) {
    const int lane = cx.tid & 63, wid = cx.tid >> 6, col = wid * 128 + lane * 2;
    const size_t row = (size_t)TP + j;
    bf16_t* AX = (bf16_t*)(p.ws + O_AX) + row * D + col;
    const float* PART = (const float*)(p.ws + O_PART) + (size_t)j * D + col;
    const unsigned w = *(const unsigned*)AX;
    float x0 = bflo(w), x1 = bfhi(w);
#pragma unroll
    for (int kc = 0; kc < 4; ++kc) { const f32x2_t q = *(const f32x2_t*)(PART + (size_t)kc * 128 * D); x0 += q[0]; x1 += q[1]; }
    *(unsigned*)AX = cvt_pk(x0, x1);
    const float ss = wave_sum(x0 * x0 + x1 * x1);
    float* RSQ = (float*)(p.ws + O_RSQ) + row * 16;
    if (lane == 0) { RSQ[wid] = ss; RSQ[8 + wid] = 0.f; }
}

struct EpiOut {
    static constexpr bool PERM = true, AFTER_DRAIN = false;
    const P* p; int l;
    DEV void operator()(const f32x4 (&acc)[2][2][4][2], const pg8::Unit& u, int wr, int wc, int fr, int fq) const {
        bf16_t* AX = (bf16_t*)(p->ws + O_AX); float* RSQ = (float*)(p->ws + O_RSQ);
#pragma unroll
        for (int ai = 0; ai < 2; ++ai) {
            u32x4 rw[4][2];
#pragma unroll
            for (int m = 0; m < 4; ++m)
#pragma unroll
                for (int bj = 0; bj < 2; ++bj)
                    rw[m][bj] = *(const u32x4*)(AX + (size_t)(u.pm * 256 + ai * 128 + wr * 64 + m * 16 + fr) * D + u.pn * 256 + bj * 128 + wc * 32 + 8 * fq);
#pragma unroll
            for (int m = 0; m < 4; ++m) {
                const int row = u.pm * 256 + ai * 128 + wr * 64 + m * 16 + fr;
                float ss = 0.f;
#pragma unroll
                for (int bj = 0; bj < 2; ++bj) {
                    const int col = u.pn * 256 + bj * 128 + wc * 32 + 8 * fq;
                    const u32x4 w = rw[m][bj];
                    f32x4 x0 = acc[ai][bj][m][0], x1 = acc[ai][bj][m][1];
                    x0[0] += bflo(w.x); x0[1] += bfhi(w.x); x0[2] += bflo(w.y); x0[3] += bfhi(w.y);
                    x1[0] += bflo(w.z); x1[1] += bfhi(w.z); x1[2] += bflo(w.w); x1[3] += bfhi(w.w);
                    u32x4 o; o.x = cvt_pk(x0[0], x0[1]); o.y = cvt_pk(x0[2], x0[3]); o.z = cvt_pk(x1[0], x1[1]); o.w = cvt_pk(x1[2], x1[3]);
                    *(u32x4*)(AX + (size_t)row * D + col) = o;
                    ss += (x0[0] * x0[0] + x0[1] * x0[1]) + (x0[2] * x0[2] + x0[3] * x0[3]) + (x1[0] * x1[0] + x1[1] * x1[1]) + (x1[2] * x1[2] + x1[3] * x1[3]);
                }
                ss += __shfl_xor(ss, 16); ss += __shfl_xor(ss, 32);
                if (fq == 0) RSQ[row * 16 + u.pn * 4 + wc] = ss;
            }
        }
    }
};

struct EpiFinal {
    static constexpr bool PERM = true, AFTER_DRAIN = true;
    const P* p;
    DEV void fused(f32x4 (&acc)[2][2][4][2], const pg8::Unit& u, int wr, int wc, int fr, int fq, PG8_LAS unsigned char* lds, int wid, int lane) const {
        const bf16_t* AX = (const bf16_t*)(p->ws + O_AX);
        PG8_LAS float* Pt = (PG8_LAS float*)lds;
        PG8_LAS float* St = (PG8_LAS float*)(lds + 8192);
        float* X = (float*)(p->ws + O_FX); unsigned* cnt = (unsigned*)(p->ws + O_FCNT) + 64 * u.pm;
#pragma unroll
        for (int ai = 0; ai < 2; ++ai) {
            u32x4 rw[4][2];
#pragma unroll
            for (int m = 0; m < 4; ++m)
#pragma unroll
                for (int bj = 0; bj < 2; ++bj)
                    rw[m][bj] = __builtin_nontemporal_load((const u32x4*)(AX + (size_t)(u.pm * 256 + ai * 128 + wr * 64 + m * 16 + fr) * D + u.pn * 256 + bj * 128 + wc * 32 + 8 * fq));
#pragma unroll
            for (int m = 0; m < 4; ++m) {
                float ss = 0.f;
#pragma unroll
                for (int bj = 0; bj < 2; ++bj) {
                    const u32x4 w = rw[m][bj];
                    f32x4 x0 = acc[ai][bj][m][0], x1 = acc[ai][bj][m][1];
                    x0[0] += bflo(w.x); x0[1] += bfhi(w.x); x0[2] += bflo(w.y); x0[3] += bfhi(w.y);
                    x1[0] += bflo(w.z); x1[1] += bfhi(w.z); x1[2] += bflo(w.w); x1[3] += bfhi(w.w);
                    acc[ai][bj][m][0] = x0; acc[ai][bj][m][1] = x1;
                    ss += (x0[0] * x0[0] + x0[1] * x0[1]) + (x0[2] * x0[2] + x0[3] * x0[3]) + (x1[0] * x1[0] + x1[1] * x1[1]) + (x1[2] * x1[2] + x1[3] * x1[3]);
                }
                ss += __shfl_xor(ss, 16); ss += __shfl_xor(ss, 32);
                if (fq == 0) Pt[(ai * 128 + wr * 64 + m * 16 + fr) * 4 + wc] = ss;
            }
        }
        asm volatile("s_waitcnt lgkmcnt(0)" ::: "memory"); __builtin_amdgcn_s_barrier(); asm volatile("" ::: "memory");
        const int row = wid * 32 + (lane & 31);
        if (lane < 32) {
            const float tot = (Pt[row * 4 + 0] + Pt[row * 4 + 1]) + (Pt[row * 4 + 2] + Pt[row * 4 + 3]);
            __hip_atomic_store(X + ((size_t)(u.pm * 256 + row) * 4 + u.pn), tot, __ATOMIC_RELAXED, __HIP_MEMORY_SCOPE_AGENT);
        }
        asm volatile("s_waitcnt vmcnt(0)" ::: "memory");
        if (lane == 0) __hip_atomic_fetch_add(cnt, 1u, __ATOMIC_RELAXED, __HIP_MEMORY_SCOPE_AGENT);
        if (wid == 0) {
            unsigned spins = 0;
            while ((unsigned)__builtin_amdgcn_readfirstlane(__hip_atomic_load(cnt, __ATOMIC_RELAXED, __HIP_MEMORY_SCOPE_AGENT)) < 32u) { __builtin_amdgcn_s_sleep(2); if (++spins > (1u << 22)) break; }
            __builtin_amdgcn_fence(__ATOMIC_ACQUIRE, "agent");
        }
        asm volatile("s_waitcnt vmcnt(0) lgkmcnt(0)" ::: "memory"); __builtin_amdgcn_s_barrier(); asm volatile("" ::: "memory");
        if (lane < 32) {
            const float* sl = X + (size_t)(u.pm * 256 + row) * 4;
            float t = 0.f;
#pragma unroll
            for (int q = 0; q < 4; ++q) t += __hip_atomic_load(sl + q, __ATOMIC_RELAXED, __HIP_MEMORY_SCOPE_AGENT);
            St[row] = rsqrtf(t * (1.0f / 1024.0f) + EPS);
        }
        asm volatile("s_waitcnt lgkmcnt(0)" ::: "memory"); __builtin_amdgcn_s_barrier(); asm volatile("" ::: "memory");
        f32x4 gf[2][2];
#pragma unroll
        for (int bj = 0; bj < 2; ++bj)
#pragma unroll
            for (int n = 0; n < 2; ++n) gf[bj][n] = *(const f32x4*)(p->in[24] + u.pn * 256 + bj * 128 + wc * 32 + 8 * fq + 4 * n);
#pragma unroll
        for (int ai = 0; ai < 2; ++ai)
#pragma unroll
            for (int m = 0; m < 4; ++m) {
                const int r = ai * 128 + wr * 64 + m * 16 + fr; const float sc = St[r];
                float* y = p->out + (size_t)(u.pm * 256 + r) * D + u.pn * 256 + wc * 32 + 8 * fq;
#pragma unroll
                for (int bj = 0; bj < 2; ++bj)
#pragma unroll
                    for (int n = 0; n < 2; ++n) *(f32x4*)(y + bj * 128 + 4 * n) = acc[ai][bj][m][n] * sc * gf[bj][n];
            }
    }
};

DEV void sample_final(const Ctx cx, const P& p, int j, unsigned char* lds) {
    const int lane = cx.tid & 63, wid = cx.tid >> 6, col = wid * 128 + lane * 2;
    const size_t row = (size_t)TP + j;
    const bf16_t* AX = (const bf16_t*)(p.ws + O_AX) + row * D + col;
    const float* PART = (const float*)(p.ws + O_PART) + (size_t)j * D + col;
    const unsigned w = __builtin_nontemporal_load((const unsigned*)AX);
    float x0 = bflo(w), x1 = bfhi(w);
#pragma unroll
    for (int kc = 0; kc < 4; ++kc) { const f32x2_t q = __builtin_nontemporal_load((const f32x2_t*)(PART + (size_t)kc * 128 * D)); x0 += q[0]; x1 += q[1]; }
    const float ss = wave_sum(x0 * x0 + x1 * x1);
    float* red = (float*)lds;
    __syncthreads();
    if (lane == 0) red[wid] = ss;
    __syncthreads();
    float t = 0.f;
#pragma unroll
    for (int q = 0; q < 8; ++q) t += red[q];
    const float sc = rsqrtf(t * (1.0f / 1024.0f) + EPS);
    const f32x2_t g = *(const f32x2_t*)(p.in[24] + col);
    f32x2_t y; y[0] = x0 * sc * g[0]; y[1] = x1 * sc * g[1];
    *(f32x2_t*)(p.out + row * D + col) = y;
}

DEV void phase_outproj(const Ctx cx, const P& p, int l, unsigned char* lds) {
    pg8::Gemm g{(const bf16_t*)(p.ws + O_MIX), (const bf16_t*)(p.ws + O_BTOUT) + (size_t)l * D * D, TP, D, D};
    pg8::StaticOrder S; S.init(TP, D, cx.G, cx.bid);
    if (l == 1 && cx.G == 256) {
        EpiFinal E{&p};
        pg8::gemm_phase<EpiFinal, pg8::StaticOrder>(cx.tid, (PG8_LAS unsigned char*)lds, g, S, E, nullptr);
        for (int j = cx.bid; j < TS; j += cx.G) sample_final(cx, p, j, lds);
        return;
    }
    EpiOut E{&p, l};
    pg8::gemm_phase<EpiOut, pg8::StaticOrder>(cx.tid, (PG8_LAS unsigned char*)lds, g, S, E, nullptr);
    for (int j = cx.bid; j < TS; j += cx.G) sample_finalize(cx, p, j);
}

DEV void phase_final(const Ctx cx, const P& p) {
    const int lane = cx.tid & 63, wid = cx.tid >> 6;
    const float* RSQ = (const float*)(p.ws + O_RSQ);
    const bf16_t* AX = (const bf16_t*)(p.ws + O_AX);
    f32x4 g[2][2];
#pragma unroll
    for (int i = 0; i < 2; ++i) { g[i][0] = *(const f32x4*)(p.in[24] + i * 512 + lane * 8); g[i][1] = *(const f32x4*)(p.in[24] + i * 512 + lane * 8 + 4); }
    for (int row0 = (cx.bid * 8 + wid) * 4; row0 < MT; row0 += cx.G * 32) {
        u32x4 w[4][2]; float qs[4];
#pragma unroll
        for (int rr = 0; rr < 4; ++rr) {
            const int row = row0 + rr;
            qs[rr] = (lane < 16) ? RSQ[row * 16 + lane] : 0.f;
#pragma unroll
            for (int i = 0; i < 2; ++i) w[rr][i] = *(const u32x4*)(AX + (size_t)row * D + i * 512 + lane * 8);
        }
#pragma unroll
        for (int rr = 0; rr < 4; ++rr) {
            const float r = rsqrtf(wave_sum(qs[rr]) * (1.0f / 1024.0f) + EPS);
            float* y = p.out + (size_t)(row0 + rr) * D;
#pragma unroll
            for (int i = 0; i < 2; ++i) {
                const u32x4 ww = w[rr][i]; const f32x4 g0 = g[i][0], g1 = g[i][1];
                f32x4 a, b;
                a[0] = bflo(ww.x) * r * g0[0]; a[1] = bfhi(ww.x) * r * g0[1]; a[2] = bflo(ww.y) * r * g0[2]; a[3] = bfhi(ww.y) * r * g0[3];
                b[0] = bflo(ww.z) * r * g1[0]; b[1] = bfhi(ww.z) * r * g1[1]; b[2] = bflo(ww.w) * r * g1[2]; b[3] = bfhi(ww.w) * r * g1[3];
                *(f32x4*)(y + i * 512 + lane * 8) = a; *(f32x4*)(y + i * 512 + lane * 8 + 4) = b;
            }
        }
    }
}

#define XB_TMO      128
#define XB_XCNT(j)  (256  + 64 * (j))
#define XB_XSUB(j)  (1280 + 64 * (j))
#define XB_XGEN(j)  (2304 + 64 * (j))
#define XB_TOP      3328
#define XB_TOPGEN   3392
#define XCD_BAR_WORDS 3456
#define XB_SPIN_CAP (1u << 18)
#define XB_LAS __attribute__((address_space(3)))

__device__ __forceinline__ unsigned xb_ld(unsigned* p)              { return __hip_atomic_load(p, __ATOMIC_RELAXED, __HIP_MEMORY_SCOPE_AGENT); }
__device__ __forceinline__ unsigned xb_add(unsigned* p, unsigned v) { return __hip_atomic_fetch_add(p, v, __ATOMIC_RELAXED, __HIP_MEMORY_SCOPE_AGENT); }
__device__ __forceinline__ unsigned xb_xcc_id() { return (unsigned)__builtin_amdgcn_s_getreg((3 << 11) | 20) & 0xFu; }
#define XB_SPIN(cond, bar) do { unsigned _sp = 0; while (cond) { __builtin_amdgcn_s_sleep(1); \
    if ((++_sp & 255u) == 0u) { if (xb_ld(&(bar)[XB_TMO])) break; if (_sp > XB_SPIN_CAP) { atomicAdd(&(bar)[XB_TMO], 1u); break; } } } } while (0)

struct XcdBarrier {
    unsigned* bar; unsigned x;
    volatile XB_LAS unsigned* st;
};

__device__ __forceinline__ XcdBarrier xcd_barrier_post(unsigned* bar, volatile XB_LAS unsigned* st) {
    XcdBarrier b; b.bar = bar; b.x = xb_xcc_id(); b.st = st;
    if (threadIdx.x == 0) (void)xb_add(&bar[XB_XCNT(b.x)], 1u);
    return b;
}
__device__ __forceinline__ void xcd_barrier_complete(unsigned* bar, unsigned x, unsigned& nloc, unsigned& nx) {
    const unsigned G = gridDim.x * gridDim.y * gridDim.z;
    unsigned sum, cnt, mine, sp = 0u;
    for (;;) {
        sum = 0u; cnt = 0u; mine = 0u;
#pragma unroll
        for (unsigned j = 0; j < 16; ++j) { const unsigned c = xb_ld(&bar[XB_XCNT(j)]); sum += c; cnt += (c > 0u) ? 1u : 0u; mine = (j == x) ? c : mine; }
        if (sum == G) break;
        __builtin_amdgcn_s_sleep(1);
        if ((++sp & 255u) == 0u) { if (xb_ld(&bar[XB_TMO])) break; if (sp > XB_SPIN_CAP) { atomicAdd(&bar[XB_TMO], 1u); break; } }
    }
    nloc = mine > 0u ? mine : 1u; nx = cnt > 0u ? cnt : 1u;
}

__device__ __forceinline__ void xcd_barrier(const XcdBarrier& b) {
    asm volatile("s_waitcnt vmcnt(0)" ::: "memory");
    __syncthreads();
    if (threadIdx.x == 0) {
        unsigned* bar = b.bar;
        __builtin_amdgcn_s_waitcnt(0);
        unsigned nloc = b.st[0], nx = b.st[1];
        if (nloc == 0u) { xcd_barrier_complete(bar, b.x, nloc, nx); b.st[0] = nloc; b.st[1] = nx; }
        const unsigned old = xb_add(&bar[XB_XSUB(b.x)], 1u);
        const unsigned gen = old / nloc;
        if (old + 1u == (gen + 1u) * nloc) {
            __builtin_amdgcn_fence(__ATOMIC_RELEASE, "agent");
            asm volatile("s_waitcnt vmcnt(0)" ::: "memory");
            const unsigned og = xb_add(&bar[XB_TOP], 1u);
            const unsigned tg = og / nx;
            if (og + 1u == (tg + 1u) * nx) xb_add(&bar[XB_TOPGEN], 1u);
            else XB_SPIN(xb_ld(&bar[XB_TOPGEN]) == tg, bar);
            __builtin_amdgcn_fence(__ATOMIC_ACQUIRE, "agent");
            xb_add(&bar[XB_XGEN(b.x)], 1u);
            asm volatile("s_waitcnt vmcnt(0)" ::: "memory");
        } else {
            XB_SPIN(xb_ld(&bar[XB_XGEN(b.x)]) == gen, bar);
            __builtin_amdgcn_fence(__ATOMIC_ACQUIRE, "agent");
            asm volatile("s_waitcnt vmcnt(0)" ::: "memory");
        }
    }
    __syncthreads();
}

DEV void grid_bar(unsigned* ctr, unsigned target) {
    asm volatile("s_waitcnt vmcnt(0) lgkmcnt(0)" ::: "memory");
    __syncthreads();
    if (threadIdx.x == 0) {
        __builtin_amdgcn_fence(__ATOMIC_RELEASE, "agent");
        asm volatile("s_waitcnt vmcnt(0)" ::: "memory");
        __hip_atomic_fetch_add(ctr, 1u, __ATOMIC_RELAXED, __HIP_MEMORY_SCOPE_AGENT);
        unsigned spins = 0;
        while (__hip_atomic_load(ctr, __ATOMIC_RELAXED, __HIP_MEMORY_SCOPE_AGENT) < target) { __builtin_amdgcn_s_sleep(1); if (++spins > (1u << 24)) break; }
        __builtin_amdgcn_fence(__ATOMIC_ACQUIRE, "agent");
        asm volatile("s_waitcnt vmcnt(0)" ::: "memory");
    }
    __syncthreads();
}

__global__ void __launch_bounds__(NTHR) hymba_fwd(P p) {
    __shared__ __attribute__((aligned(16))) unsigned char lds[LDS_BYTES];
    cg::grid_group grid = cg::this_grid();
    if (blockIdx.x == 0 && p.ph_lo == 0) for (int i = threadIdx.x; i < 3456; i += NTHR) __hip_atomic_store((unsigned*)(p.ws + O_XBAR) + i, 0u, __ATOMIC_RELAXED, __HIP_MEMORY_SCOPE_AGENT);
    if (blockIdx.x == 1 && p.ph_lo == 0 && threadIdx.x < 64) __hip_atomic_store((unsigned*)(p.ws + O_FCNT) + 64 * threadIdx.x, 0u, __ATOMIC_RELAXED, __HIP_MEMORY_SCOPE_AGENT);
    volatile XB_LAS unsigned* xst = (volatile XB_LAS unsigned*)(lds + LDS_BYTES - 16);
    if (threadIdx.x < 4) xst[threadIdx.x] = 0u;
    __syncthreads();
    int nbar = 0;
    for (int ph = p.ph_lo; ph < p.ph_hi; ++ph) {
        if (ph == 0) { grid.sync(); (void)xcd_barrier_post((unsigned*)(p.ws + O_XBAR), (volatile XB_LAS unsigned*)(lds + LDS_BYTES - 16)); }
        Ctx cx; { int t_ = threadIdx.x, b_ = blockIdx.x, g_ = gridDim.x; asm volatile("" : "+v"(t_)); asm volatile("" : "+s"(b_)); asm volatile("" : "+s"(g_)); cx.tid = t_; cx.bid = b_; cx.G = g_; }
#ifndef PHMASK
#define PHMASK 0xff
#endif
        if (ph == 0) { if (PHMASK & 1) phase_prep(cx, p, lds, (cx.G == 256) ? 0 : 2, cx.bid, cx.G); }
        else if (ph == NPHASE - 1) { if ((PHMASK & 2) && cx.G != 256) phase_final(cx, p); }
        else {
            const int l = (ph - 1) / 6, s = (ph - 1) % 6;
#ifndef REPMASK
#define REPMASK 0
#endif
            if (s == 0) { if (PHMASK & 4) phase_inproj(cx, p, l, lds); if (REPMASK & 1) phase_inproj(cx, p, l, lds); }
            else if (s == 1) { if (PHMASK & 8) phase_b1(cx, p, l, lds); if (REPMASK & 2) phase_b1(cx, p, l, lds); }
            else if (s == 2) { if (PHMASK & 16) phase_b2(cx, p, l, lds); }
            else if (s == 3) { if (PHMASK & 32) phase_b3(cx, p, l, lds); if (REPMASK & 4) phase_b3(cx, p, l, lds); }
            else if (s == 4) { if (PHMASK & 64) phase_b4(cx, p, l, lds); if (REPMASK & 64) phase_b4(cx, p, l, lds); }
            else { if (PHMASK & 128) phase_outproj(cx, p, l, lds); if ((REPMASK & 128) && l == 0) phase_outproj(cx, p, l, lds); }
        }
        if (ph + 1 < p.ph_hi && !(ph + 1 == NPHASE - 1 && gridDim.x == 256)) {
            XcdBarrier b; b.bar = (unsigned*)(p.ws + O_XBAR); b.x = xb_xcc_id(); b.st = (volatile XB_LAS unsigned*)(lds + LDS_BYTES - 16);
            xcd_barrier(b);
        }
    }
#ifdef STOPAT
    grid.sync();
    {
        const int lane = threadIdx.x & 63, wid = threadIdx.x >> 6;
        const int nchunk = (int)(O_END / 65536);
        for (int c = blockIdx.x * 8 + wid; c < nchunk; c += gridDim.x * 8) {
            const unsigned* w = (const unsigned*)(p.ws + (size_t)c * 65536);
            unsigned sum = 0;
            for (int i = lane; i < 16384; i += 64) sum += w[i] * (unsigned)(i * 2 + 1);
            for (int o = 32; o >= 1; o >>= 1) sum += __shfl_xor(sum, o);
            if (lane == 0) p.out[c] = (float)(sum & 0xffffffu);
        }
    }
#endif
}

extern "C" void kernel_launch(void* const* d_in, const int* in_sizes, int n_in, void* d_out, int out_size, void* d_ws, size_t ws_size, hipStream_t stream) {
    static int grid_blocks = 0;
    if (grid_blocks == 0) {
        if (n_in != 25 || ws_size < O_END) { fprintf(stderr, "kernel_launch: unexpected n_in %d or workspace %zu < %zu\n", n_in, ws_size, (size_t)O_END); grid_blocks = -1; return; }
        int dev = 0, cus = 0, per_cu = 0;
        (void)hipGetDevice(&dev);
        (void)hipDeviceGetAttribute(&cus, hipDeviceAttributeMultiprocessorCount, dev);
        (void)hipOccupancyMaxActiveBlocksPerMultiprocessor(&per_cu, (const void*)hymba_fwd, NTHR, 0);
        if (per_cu < 1) { fprintf(stderr, "kernel_launch: occupancy query gave %d\n", per_cu); per_cu = 1; }
        grid_blocks = cus * 1;
        (void)hipGetLastError();
    }
    if (grid_blocks < 0) return;
    P p{};
    for (int i = 0; i < 25; ++i) p.in[i] = (const float*)d_in[i];
    p.out = (float*)d_out; p.ws = (unsigned char*)d_ws;
#if MEGA
#ifdef STOPAT
    p.ph_lo = 0; p.ph_hi = STOPAT;
#else
    p.ph_lo = 0; p.ph_hi = NPHASE;
#endif
    void* args[] = {&p};
    hipError_t e = hipLaunchCooperativeKernel((const void*)hymba_fwd, dim3(grid_blocks), dim3(NTHR), args, 0, stream);
    if (e != hipSuccess) fprintf(stderr, "cooperative launch failed: %s (grid %d)\n", hipGetErrorString(e), grid_blocks);
#else
    for (int ph = 0; ph < NPHASE; ++ph) {
        p.ph_lo = ph; p.ph_hi = ph + 1;
        hipLaunchKernelGGL(hymba_fwd, dim3(grid_blocks), dim3(NTHR), 0, stream, p);
    }
#endif
}
```

```cpp
#include <hip/hip_runtime.h>
#include <hip/hip_cooperative_groups.h>
#include <cstdio>
#include <cstdint>
namespace cg = cooperative_groups;

#define REPMASK 0
#ifndef MEGA
#define MEGA 1
#endif

typedef unsigned short bf16_t;
typedef short bf16x8 __attribute__((ext_vector_type(8)));
typedef float f32x4 __attribute__((ext_vector_type(4)));
typedef unsigned u32x4 __attribute__((ext_vector_type(4)));
typedef unsigned u32x2 __attribute__((ext_vector_type(2)));
#define DEV __device__ __forceinline__

constexpr int D = 1024, TP = 16384, TS = 128, MT = 16512, MPAD = 16640, NIN = 3216, NPERM = 3584;
constexpr float EPS = 1e-6f;
constexpr int NTHR = 512;
constexpr int LDS_BYTES = 144 * 1024;
constexpr int NPHASE = 14;

constexpr size_t al(size_t x) { return (x + 255) & ~size_t(255); }
constexpr size_t O_BTIN = 0;
constexpr size_t O_BTOUT = O_BTIN + al(2ull * NPERM * 1024 * 2);
constexpr size_t O_BTGLU = O_BTOUT + al(2ull * 1024 * 1024 * 2);
constexpr size_t O_BTS5Y = O_BTGLU + al(2ull * 256 * 256 * 2);
constexpr size_t O_BTS5S = O_BTS5Y + al(2ull * 16 * 256 * 384 * 2);
constexpr size_t O_A16 = O_BTS5S + al(2ull * 16 * 128 * 256 * 2);
constexpr size_t O_ABAR = O_A16 + al(2ull * 16 * 64 * 2 * 4);
constexpr size_t O_BB = O_ABAR + al(2ull * 16 * 64 * 2 * 4);
constexpr size_t O_LB = O_BB + al(2ull * 16 * 64 * 16 * 2 * 4);
constexpr size_t O_AX = O_LB + al(2ull * 384 * 4);
constexpr size_t O_RSQ = O_AX + al((size_t)MPAD * 1024 * 2);
constexpr size_t O_HQ = O_RSQ + al((size_t)MPAD * 16 * 4);
constexpr size_t O_HV = O_HQ + al((size_t)MPAD * 384 * 2);
constexpr size_t O_HZ = O_HV + al((size_t)MPAD * 384 * 2);
constexpr size_t O_HG = O_HZ + al((size_t)MPAD * 384 * 2);
constexpr size_t O_GQ = O_HG + al((size_t)MPAD * 384 * 4);
constexpr size_t O_GV = O_GQ + al((size_t)MPAD * 384 * 2);
constexpr size_t O_GZ = O_GV + al((size_t)MPAD * 384 * 2);
constexpr size_t O_GR = O_GZ + al((size_t)MPAD * 384 * 2);
constexpr size_t O_AS5 = O_GR + al((size_t)MPAD * 192 * 4);
constexpr size_t O_SUS = O_AS5 + al(16ull * 1024 * 384 * 2);
constexpr size_t O_YGS = O_SUS + al(128ull * 256 * 4);
constexpr size_t O_SZ = O_YGS + al(128ull * 256 * 2);
constexpr size_t O_MIX = O_SZ + al((size_t)MPAD * 256 * 2);
constexpr size_t O_DSH = O_MIX + al((size_t)MPAD * 1024 * 2);
constexpr size_t O_DDH = O_DSH + al(1536ull * 4096 * 2);
constexpr size_t O_DSG = O_DDH + al(1536ull * 64 * 4);
constexpr size_t O_DDG = O_DSG + al(1536ull * 2048 * 2);
constexpr size_t O_S5S = O_DDG + al(1536ull * 32 * 4);
constexpr size_t O_BAR = O_S5S + al(16ull * 1024 * 128 * 4);
constexpr size_t O_PART = O_BAR + 256;
constexpr size_t O_XBAR = O_PART + al(4ull * 128 * 1024 * 4);
constexpr size_t O_FX = O_XBAR + al(3456 * 4);
constexpr size_t O_FCNT = O_FX + al(16384ull * 4 * 4);
constexpr size_t O_END = O_FCNT + 64 * 256;

constexpr size_t OUT_YS = 16777216, OUT_HP = 16908288, OUT_GP = 17301504, OUT_RP = 17498112, OUT_IP = 17514496,
                 OUT_HS = 17530880, OUT_GS = 23822336, OUT_RS = 26968064, OUT_IS = 27230208;

struct P {
    const float* in[25];
    float* out;
    unsigned char* ws;
    int ph_lo, ph_hi;
};

struct Ctx { int tid, bid, G; };

DEV void lds_barrier() { asm volatile("s_waitcnt lgkmcnt(0)" ::: "memory"); __builtin_amdgcn_s_barrier(); asm volatile("" ::: "memory"); }
DEV u32x4 rot8h(u32x4 w, int r) {
    if (r & 4) w = (u32x4){w.z, w.w, w.x, w.y};
    if (r & 2) w = (u32x4){w.y, w.z, w.w, w.x};
    if (r & 1) w = (u32x4){__builtin_amdgcn_alignbit(w.y, w.x, 16), __builtin_amdgcn_alignbit(w.z, w.y, 16), __builtin_amdgcn_alignbit(w.w, w.z, 16), __builtin_amdgcn_alignbit(w.x, w.w, 16)};
    return w;
}
DEV u32x2 rot4h(u32x2 w, int r) {
    if (r & 2) w = (u32x2){w.y, w.x};
    if (r & 1) w = (u32x2){__builtin_amdgcn_alignbit(w.y, w.x, 16), __builtin_amdgcn_alignbit(w.x, w.y, 16)};
    return w;
}
DEV int vslot(int v) { return (v & ~31) + ((v >> 2) & 1) * 16 + ((v >> 3) & 3) * 4 + (v & 3); }
DEV Ctx relaunder(Ctx c) { asm volatile("" : "+v"(c.tid)); return c; }

typedef __bf16 bf16x2_t __attribute__((ext_vector_type(2)));
typedef float f32x2_t __attribute__((ext_vector_type(2)));
DEV unsigned cvt_pk(float lo, float hi) { const f32x2_t f = {lo, hi}; const bf16x2_t b = __builtin_convertvector(f, bf16x2_t); return __builtin_bit_cast(unsigned, b); }
DEV void st4bf(bf16_t* dst, f32x4 v) { u32x2 w; w.x = cvt_pk(v[0], v[1]); w.y = cvt_pk(v[2], v[3]); *(u32x2*)dst = w; }
DEV bf16_t f2bf(float f) { return (bf16_t)(cvt_pk(f, 0.f) & 0xffffu); }
DEV float bf2f(bf16_t b) { return __uint_as_float(((unsigned)b) << 16); }
DEV float bflo(unsigned w) { return __uint_as_float(w << 16); }
DEV float bfhi(unsigned w) { return __uint_as_float(w & 0xffff0000u); }
DEV float wave_sum(float v) {
#pragma unroll
    for (int o = 32; o >= 1; o >>= 1) v += __shfl_xor(v, o);
    return v;
}
DEV float rcpf_(float x) { return __builtin_amdgcn_rcpf(x); }
DEV float sigmoidf_(float x) { return rcpf_(1.0f + __expf(-x)); }
DEV float siluf_(float x) { return x * sigmoidf_(x); }
DEV float logsigf_(float x) { return fminf(x, 0.f) - log1pf(__expf(-fabsf(x))); }
DEV float geluf_(float x) { const float u = 0.7978845608028654f * (x + 0.044715f * x * x * x); const float t = 1.0f - 2.0f * rcpf_(1.0f + __expf(2.0f * u)); return 0.5f * x * (1.0f + t); }
DEV float expc(float x) { return __expf(fminf(x, 80.f)); }

DEV int perm_src(int np) {
    const int pn = np >> 8, j = np & 255;
    if (pn < 6) return (j >> 6) * 384 + pn * 64 + (j & 63);
    if (pn < 12) {
        const int h = pn - 6;
        if (j < 32) return 1536 + h * 32 + j;
        if (j < 64) return 1728 + h * 32 + (j - 32);
        if (j < 128) return 1920 + h * 64 + (j - 64);
        if (j < 192) return 2304 + h * 64 + (j - 128);
        if (j < 224) return -2 - (h * 32 + (j - 192));
        return -1;
    }
    if (pn == 12) return 2704 + j;
    return 2960 + j;
}

DEV void cis_d(double th, double& c, double& s) {
    const double n = rint(th * 0.15915494309189535);
    double r = fma(-n, 6.283185307179586, th); r = fma(-n, 2.4492935982947064e-16, r);
    const double x = r * (1.0 / 64.0), x2 = x * x;
    double sn = x * (1.0 - x2 * (1.0 / 6.0) * (1.0 - x2 * (1.0 / 20.0) * (1.0 - x2 * (1.0 / 42.0) * (1.0 - x2 * (1.0 / 72.0)))));
    double cs = 1.0 - x2 * 0.5 * (1.0 - x2 * (1.0 / 12.0) * (1.0 - x2 * (1.0 / 30.0) * (1.0 - x2 * (1.0 / 56.0) * (1.0 - x2 * (1.0 / 90.0)))));
#pragma unroll
    for (int i = 0; i < 6; ++i) { const double c2 = cs * cs - sn * sn, s2 = 2.0 * cs * sn; cs = c2; sn = s2; }
    c = cs; s = sn;
}

template <int NK>
DEV void gemm128(const Ctx cx, const bf16_t* __restrict__ A, int lda, const bf16_t* __restrict__ Bt, int ldb, int row0, int col0,
                 unsigned char* lds, f32x4 (&acc)[2][4]) {
    constexpr int LS = 136;
    const int tid = cx.tid, lane = tid & 63, wid = tid >> 6, wr = wid >> 1, wc = wid & 1, fr = lane & 15, fq = lane >> 4;
    bf16_t* sA = (bf16_t*)lds;
    bf16_t* sB = sA + 128 * LS;
    const int r0 = tid >> 4, c0 = (tid & 15) * 8;
    const bf16_t* pa = A + (size_t)(row0 + r0) * lda + c0;
    const bf16_t* pb = Bt + (size_t)(col0 + r0) * ldb + c0;
#pragma unroll
    for (int mi = 0; mi < 2; ++mi)
#pragma unroll
        for (int ni = 0; ni < 4; ++ni) acc[mi][ni] = (f32x4){0.f, 0.f, 0.f, 0.f};
    u32x4 ra[NK][4], rb[NK][4];
#pragma unroll
    for (int s = 0; s < NK; ++s)
#pragma unroll
        for (int i = 0; i < 4; ++i) { ra[s][i] = *(const u32x4*)(pa + (size_t)(32 * i) * lda + s * 128); rb[s][i] = *(const u32x4*)(pb + (size_t)(32 * i) * ldb + s * 128); }
#pragma unroll
    for (int s = 0; s < NK; ++s) {
        lds_barrier();
#pragma unroll
        for (int i = 0; i < 4; ++i) { *(u32x4*)(sA + (r0 + 32 * i) * LS + c0) = ra[s][i]; *(u32x4*)(sB + (r0 + 32 * i) * LS + c0) = rb[s][i]; }
        lds_barrier();
#pragma unroll
        for (int kk = 0; kk < 4; ++kk) {
            bf16x8 af[2], bfr[4];
#pragma unroll
            for (int mi = 0; mi < 2; ++mi) af[mi] = *(const bf16x8*)(sA + (wr * 32 + mi * 16 + fr) * LS + kk * 32 + fq * 8);
#pragma unroll
            for (int ni = 0; ni < 4; ++ni) bfr[ni] = *(const bf16x8*)(sB + (wc * 64 + ni * 16 + fr) * LS + kk * 32 + fq * 8);
#pragma unroll
            for (int mi = 0; mi < 2; ++mi)
#pragma unroll
                for (int ni = 0; ni < 4; ++ni) acc[mi][ni] = __builtin_amdgcn_mfma_f32_16x16x32_bf16(bfr[ni], af[mi], acc[mi][ni], 0, 0, 0);
        }
    }
}

DEV void s5_precompute(const Ctx cx, const P& p, int it, unsigned char* lds) {
    const int tid = cx.tid;
    const int l = it >> 4, g = it & 15, lg = it;
    float* Ap = (float*)lds;
    float* Bbs = Ap + 17 * 64 * 2;
    float* Cs = Bbs + 64 * 16 * 2;
    float* Km = Cs + 16 * 64 * 2;
    unsigned char* ws = p.ws;
    __syncthreads();
    const float dt = expf(p.in[20][lg]);
    for (int e = tid; e < 17 * 64; e += NTHR) {
        const int j = e >> 6, pp = e & 63;
        const float lr = p.in[13][lg * 64 + pp], li = p.in[14][lg * 64 + pp];
        const float mag = expf((float)j * lr * dt);
        double c, s; cis_d((double)li * (double)dt * (double)j, c, s);
        Ap[e * 2] = mag * (float)c; Ap[e * 2 + 1] = mag * (float)s;
    }
    __syncthreads();
    float* BBg = (float*)(ws + O_BB);
    for (int e = tid; e < 64 * 16; e += NTHR) {
        const int pp = e >> 4, cc = e & 15;
        const float lr = p.in[13][lg * 64 + pp], li = p.in[14][lg * 64 + pp];
        const float abr = Ap[(64 + pp) * 2], abi = Ap[(64 + pp) * 2 + 1], nr = abr - 1.0f, den = lr * lr + li * li;
        const float cor = (nr * lr + abi * li) / den, coi = (abi * lr - nr * li) / den;
        const float Br = p.in[15][(lg * 64 + pp) * 16 + cc], Bi = p.in[16][(lg * 64 + pp) * 16 + cc];
        const float bbr = cor * Br - coi * Bi, bbi = cor * Bi + coi * Br;
        Bbs[e * 2] = bbr; Bbs[e * 2 + 1] = bbi;
        BBg[((size_t)(lg * 64 + pp) * 16 + cc) * 2] = bbr; BBg[((size_t)(lg * 64 + pp) * 16 + cc) * 2 + 1] = bbi;
    }
    for (int e = tid; e < 16 * 64; e += NTHR) {
        const int cc = e >> 6, pp = e & 63;
        Cs[e * 2] = p.in[17][(lg * 16 + cc) * 64 + pp]; Cs[e * 2 + 1] = p.in[18][(lg * 16 + cc) * 64 + pp];
    }
    if (tid < 64) {
        float* A16 = (float*)(ws + O_A16); float* AB = (float*)(ws + O_ABAR);
        A16[(lg * 64 + tid) * 2] = Ap[(16 * 64 + tid) * 2]; A16[(lg * 64 + tid) * 2 + 1] = Ap[(16 * 64 + tid) * 2 + 1];
        AB[(lg * 64 + tid) * 2] = Ap[(64 + tid) * 2]; AB[(lg * 64 + tid) * 2 + 1] = Ap[(64 + tid) * 2 + 1];
    }
    __syncthreads();
    for (int e = tid; e < 4096; e += NTHR) {
        const int j = e >> 8, c = (e >> 4) & 15, c2 = e & 15;
        float acc = 0.f;
        for (int pp = 0; pp < 64; ++pp) {
            const float cr = Cs[(c * 64 + pp) * 2], ci = Cs[(c * 64 + pp) * 2 + 1], ar = Ap[(j * 64 + pp) * 2], ai = Ap[(j * 64 + pp) * 2 + 1];
            const float br = Bbs[(pp * 16 + c2) * 2], bi = Bbs[(pp * 16 + c2) * 2 + 1];
            const float car = cr * ar - ci * ai, cai = cr * ai + ci * ar;
            acc += car * br - cai * bi;
        }
        if (j == 0 && c == c2) acc += p.in[19][l * 256 + g * 16 + c];
        Km[e] = acc;
    }
    __syncthreads();
    bf16_t* Y = (bf16_t*)(ws + O_BTS5Y) + (size_t)lg * 256 * 384;
    for (int e = tid; e < 256 * 384; e += NTHR) {
        const int n = e / 384, k = e - n * 384, i = n >> 4, c = n & 15;
        float v;
        if (k < 256) { const int j = k >> 4, c2 = k & 15; v = (j <= i) ? Km[((i - j) * 16 + c) * 16 + c2] : 0.f; }
        else { const int pp = (k - 256) & 63, imf = (k - 256) >> 6;
            const float cr = Cs[(c * 64 + pp) * 2], ci = Cs[(c * 64 + pp) * 2 + 1], ar = Ap[((i + 1) * 64 + pp) * 2], ai = Ap[((i + 1) * 64 + pp) * 2 + 1];
            v = imf ? -(cr * ai + ci * ar) : (cr * ar - ci * ai); }
        Y[e] = f2bf(v);
    }
    bf16_t* S = (bf16_t*)(ws + O_BTS5S) + (size_t)lg * 128 * 256;
    for (int e = tid; e < 128 * 256; e += NTHR) {
        const int n = e >> 8, k = e & 255, pp = n & 63, imf = n >> 6, j = k >> 4, c2 = k & 15;
        const float ar = Ap[((15 - j) * 64 + pp) * 2], ai = Ap[((15 - j) * 64 + pp) * 2 + 1], br = Bbs[(pp * 16 + c2) * 2], bi = Bbs[(pp * 16 + c2) * 2 + 1];
        S[e] = f2bf(imf ? (ar * bi + ai * br) : (ar * br - ai * bi));
    }
}

DEV void phase_prep(const Ctx cx, const P& p, unsigned char* lds, int part, int vb, int VG) {
    const int tid = cx.tid, lane = tid & 63, wid = tid >> 6;
    unsigned char* ws = p.ws;
    int G = VG, bid = vb;
    if (part != 0) {
        const bool split = VG > 64;
        if (!split || vb < 32) for (int it = vb; it < 32; it += VG) s5_precompute(cx, p, it, lds);
        if (split && vb < 32) return;
        if (split) { G = VG - 32; bid = vb - 32; }
    }
    if (part != 1)
    {
        bf16_t* AX = (bf16_t*)(ws + O_AX); float* RSQ = (float*)(ws + O_RSQ);
        for (int row0 = (bid * 8 + wid) * 4; row0 < MPAD; row0 += G * 32) {
            f32x4 v[4][4];
#pragma unroll
            for (int rr = 0; rr < 4; ++rr) {
                const int row = row0 + rr;
                const float* src = row < TP ? p.in[0] + (size_t)row * D : (row < MT ? p.in[1] + (size_t)(row - TP) * D : nullptr);
#pragma unroll
                for (int i = 0; i < 4; ++i) { v[rr][i] = (f32x4){0.f, 0.f, 0.f, 0.f}; if (src) v[rr][i] = __builtin_nontemporal_load((const f32x4*)(src + i * 256 + lane * 4)); }
            }
#pragma unroll
            for (int rr = 0; rr < 4; ++rr) {
                const int row = row0 + rr;
                float ss = 0.f;
#pragma unroll
                for (int i = 0; i < 4; ++i) {
                    const f32x4 x = v[rr][i];
                    ss += x[0] * x[0] + x[1] * x[1] + x[2] * x[2] + x[3] * x[3];
                    st4bf(AX + (size_t)row * D + i * 256 + lane * 4, x);
                }
                ss = wave_sum(ss);
                if (lane < 16) RSQ[row * 16 + lane] = (lane == 0) ? ss : 0.f;
            }
        }
    }
    const int gt = bid * NTHR + tid, GT = G * NTHR;
    const int bt_lo = (part == 1) ? NPERM * 128 : 0, bt_hi = (part == 0) ? NPERM * 128 : 2 * NPERM * 128;
    for (int idx0 = bt_lo + gt; idx0 < bt_hi; idx0 += 4 * GT) {
        float v[4][8]; int nn[4];
#pragma unroll
        for (int u = 0; u < 4; ++u) {
            const int idx = idx0 + u * GT;
            nn[u] = -1;
#pragma unroll
            for (int e = 0; e < 8; ++e) v[u][e] = 0.f;
            if (idx < bt_hi) {
                const int np = idx % NPERM, k8 = ((idx / NPERM) & 127) * 8, l = idx / (NPERM * 128);
                nn[u] = perm_src(np);
                if (nn[u] >= 0) {
                    const float* W = p.in[7] + (size_t)l * D * NIN + nn[u];
#pragma unroll
                    for (int e = 0; e < 8; ++e) v[u][e] = __builtin_nontemporal_load(W + (size_t)(k8 + e) * NIN);
                }
            }
        }
#pragma unroll
        for (int u = 0; u < 4; ++u) {
            const int idx = idx0 + u * GT;
            if (idx < bt_hi) {
                const int np = idx % NPERM, k8 = ((idx / NPERM) & 127) * 8, l = idx / (NPERM * 128);
                const float* g = p.in[6] + l * D + k8;
                if (nn[u] <= -2) {
                    const int gc = -2 - nn[u];
                    const float* W = p.in[7] + (size_t)l * D * NIN + 2688; const float* w2 = p.in[10] + (size_t)l * 16 * 192 + gc;
                    for (int r = 0; r < 16; ++r) {
                        const float c = w2[r * 192];
#pragma unroll
                        for (int e = 0; e < 8; ++e) v[u][e] += W[(size_t)(k8 + e) * NIN + r] * c;
                    }
                }
                u32x4 w;
                w.x = cvt_pk(v[u][0] * g[0], v[u][1] * g[1]); w.y = cvt_pk(v[u][2] * g[2], v[u][3] * g[3]); w.z = cvt_pk(v[u][4] * g[4], v[u][5] * g[5]); w.w = cvt_pk(v[u][6] * g[6], v[u][7] * g[7]);
                *(u32x4*)((bf16_t*)(ws + O_BTIN) + ((size_t)l * NPERM + np) * D + k8) = w;
            }
        }
    }
    if (part != 0)
    for (int idx0 = gt; idx0 < 2 * 1024 * 128; idx0 += 4 * GT) {
        float v[4][8];
#pragma unroll
        for (int u = 0; u < 4; ++u) {
            const int idx = idx0 + u * GT;
#pragma unroll
            for (int e = 0; e < 8; ++e) v[u][e] = 0.f;
            if (idx < 2 * 1024 * 128) {
                const int d = idx & 1023, e8 = ((idx >> 10) & 127) * 8, l = idx >> 17;
                const float* W = p.in[23] + (size_t)l * D * D + d;
#pragma unroll
                for (int e = 0; e < 8; ++e) v[u][e] = __builtin_nontemporal_load(W + (size_t)(e8 + e) * D);
            }
        }
#pragma unroll
        for (int u = 0; u < 4; ++u) {
            const int idx = idx0 + u * GT;
            if (idx < 2 * 1024 * 128) {
                const int d = idx & 1023, e8 = ((idx >> 10) & 127) * 8, l = idx >> 17;
                u32x4 w; w.x = cvt_pk(v[u][0], v[u][1]); w.y = cvt_pk(v[u][2], v[u][3]); w.z = cvt_pk(v[u][4], v[u][5]); w.w = cvt_pk(v[u][6], v[u][7]);
                *(u32x4*)((bf16_t*)(ws + O_BTOUT) + ((size_t)l * D + d) * D + e8) = w;
            }
        }
    }
    if (part != 0)
    for (int idx = gt; idx < 2 * 256 * 32; idx += GT) {
        const int n = idx & 255, i8 = ((idx >> 8) & 31) * 8, l = idx >> 13;
        const float* W = p.in[21] + (size_t)l * 65536 + n;
        float v[8];
#pragma unroll
        for (int e = 0; e < 8; ++e) v[e] = W[(size_t)(i8 + e) * 256];
        u32x4 w; w.x = cvt_pk(v[0], v[1]); w.y = cvt_pk(v[2], v[3]); w.z = cvt_pk(v[4], v[5]); w.w = cvt_pk(v[6], v[7]);
        *(u32x4*)((bf16_t*)(ws + O_BTGLU) + ((size_t)l * 256 + n) * 256 + i8) = w;
    }
    if (part != 1)
    for (int idx = gt; idx < 384; idx += GT) {
        const float l0 = p.in[8][idx], l1 = p.in[8][384 + idx], m = fmaxf(l0, l1), e0 = expf(l0 - m), e1 = expf(l1 - m);
        float* LB = (float*)(ws + O_LB);
        LB[idx] = 0.f; LB[384 + idx] = e1 / (e0 + e1);
    }
}

namespace pg8 {
#define PG8_LAS __attribute__((address_space(3)))
typedef unsigned short bf16_t;
typedef short bf16x8 __attribute__((ext_vector_type(8)));
typedef float f32x4 __attribute__((ext_vector_type(4)));
typedef unsigned u32x4 __attribute__((ext_vector_type(4)));
constexpr int BM = 256, BK = 64, HALF = 128, HTB = HALF * BK * 2  , STAGE_BYTES = 8 * HTB, NXCD = 8, WGM = 8;

__host__ __device__ __forceinline__ int lds_byte(int r, int c) { const int st = (r >> 4) * 2 + (c >> 5), rr = r & 15, cc = c & 31, ob = rr * 64 + cc * 2; return st * 1024 + (ob ^ (((ob >> 9) & 1) << 5)); }
__host__ __device__ __forceinline__ void stage_rc(int b, int& R, int& C) { const int st = b / 1024, sb = b % 1024, swz = sb ^ (((sb >> 9) & 1) << 5); R = (st >> 1) * 16 + swz / 64; C = (st & 1) * 32 + (swz % 64) / 2; }
__host__ __device__ __forceinline__ int perm32(int rho) { const int n = rho >> 4, i = rho & 15; return 8 * (i >> 2) + 4 * n + (i & 3); }

struct Unit { int pm, pn; };
struct Gemm { const bf16_t* A; const bf16_t* Bt; int M, N, K; };

struct StaticOrder {
    int nM, nN, nwg, G, c;
    __host__ __device__ void init(int M, int N, int G_, int c_) { nM = M / BM; nN = N / BM; nwg = nM * nN; G = G_; c = c_; }
    __host__ __device__ bool next(int i, Unit& u) const {
        const long L = (long)i * G + c; if (L >= nwg) return false;
        int wgid = (int)L; { const int q = nwg / NXCD, r = nwg % NXCD, xcd = wgid % NXCD, off = wgid / NXCD; wgid = (xcd < r ? xcd * (q + 1) : r * (q + 1) + (xcd - r) * q) + off; }
        const int nig = WGM * nN, gid = wgid / nig, fm = gid * WGM, gsz = (nM - fm) < WGM ? (nM - fm) : WGM;
        u.pm = fm + ((wgid % nig) % gsz); u.pn = (wgid % nig) / gsz; return true;
    }
    __device__ __forceinline__ void a_ready(const Unit&) const {}
    __device__ __forceinline__ void done(const Unit&) const {}
};
template <class Epi, class Sched, bool STAMP = false>
__device__ __forceinline__ void gemm_phase(const int tid, PG8_LAS unsigned char* lds, const Gemm g, const Sched& S, const Epi& E, unsigned long long* stamps) {
    const int wid = __builtin_amdgcn_readfirstlane(tid >> 6), lane = tid & 63, wr = wid >> 2, wc = wid & 3, fr = lane & 15, fq = lane >> 4;
    const int K = g.K, nt = K / BK;
    int ts_lo = 0, ts_hi = 0, nts = 0; const unsigned long long rt_entry = STAMP ? (unsigned long long)wall_clock64() : 0ull;
#define PG8_STAMP() do { if (STAMP && wid == 0 && nts < 64) { const unsigned long long _c = (unsigned long long)clock64(); \
        ts_lo = (lane == nts) ? (int)(unsigned)_c : ts_lo; ts_hi = (lane == nts) ? (int)(unsigned)(_c >> 32) : ts_hi; ++nts; } } while (0)
    PG8_STAMP();
    unsigned voffA[2], voffB[2];
#pragma unroll
    for (int i = 0; i < 2; ++i) { int R, C; stage_rc(tid * 16 + i * 8192, R, C); const int Rb = Epi::PERM ? ((R & ~31) + perm32(R & 31)) : R;
        voffA[i] = (unsigned)(R * K + C) * 2u; voffB[i] = (unsigned)(Rb * K + C) * 2u; }
    const size_t kstep = (size_t)(BK * 2);
    const size_t hstep = (size_t)HALF * K * 2;
    const size_t tstep = 2 * hstep;
    const unsigned ldsw = (unsigned)wid * 1024u;
    const int aoff = lds_byte(wr * 64 + fr, fq * 8), boff = lds_byte(wc * 32 + fr, fq * 8);
#define PG8_SA(b, h) (((b) * 2 + (h)) * HTB)
#define PG8_SB(b, h) ((4 + (b) * 2 + (h)) * HTB)
#define PG8_STAGE(bufoff, gbase, voff) do { _Pragma("unroll") for (int _i = 0; _i < 2; ++_i) \
        __builtin_amdgcn_global_load_lds((const unsigned*)((const char*)(gbase) + (voff)[_i]), (PG8_LAS unsigned*)(lds + (bufoff) + ldsw + _i * 8192), 16, 0, 0); } while (0)
#define PG8_LDA(dst, b, h) do { _Pragma("unroll") for (int m = 0; m < 4; ++m) _Pragma("unroll") for (int k = 0; k < 2; ++k) dst[m][k] = *(const PG8_LAS bf16x8*)(lds + PG8_SA(b, h) + aoff + m * 2048 + k * 1024); } while (0)
#define PG8_LDB(dst, b, h) do { _Pragma("unroll") for (int n = 0; n < 2; ++n) _Pragma("unroll") for (int k = 0; k < 2; ++k) dst[n][k] = *(const PG8_LAS bf16x8*)(lds + PG8_SB(b, h) + boff + n * 2048 + k * 1024); } while (0)
#define PG8_MMA(ai, bj, At, Bt) do { __builtin_amdgcn_s_setprio(1); _Pragma("unroll") for (int m = 0; m < 4; ++m) _Pragma("unroll") for (int n = 0; n < 2; ++n) _Pragma("unroll") for (int k = 0; k < 2; ++k) \
        acc[ai][bj][m][n] = __builtin_amdgcn_mfma_f32_16x16x32_bf16(Bt[n][k], At[m][k], acc[ai][bj][m][n], 0, 0, 0); __builtin_amdgcn_s_setprio(0); } while (0)
#define PG8_WAIT_V(n) asm volatile("s_waitcnt vmcnt(" #n ")" ::: "memory")
#define PG8_WAIT_L(n) asm volatile("s_waitcnt lgkmcnt(" #n ")" ::: "memory")
#define PG8_BAR __builtin_amdgcn_s_barrier()
#define PG8_SCHED __builtin_amdgcn_sched_barrier(0)
    Unit cur, nxt; int ui = 0;
    if (!S.next(0, cur)) return;
    f32x4 acc[2][2][4][2];
#pragma unroll
    for (int a = 0; a < 2; ++a)
#pragma unroll
        for (int b = 0; b < 2; ++b)
#pragma unroll
            for (int m = 0; m < 4; ++m)
#pragma unroll
                for (int n = 0; n < 2; ++n) acc[a][b][m][n] = (f32x4){0.f, 0.f, 0.f, 0.f};
    bf16x8 At[4][2], B0[2][2], B1[2][2];
    const char* cA = (const char*)g.A + (size_t)cur.pm * tstep; const char* cB = (const char*)g.Bt + (size_t)cur.pn * tstep;
    S.a_ready(cur);
    PG8_STAGE(PG8_SB(0, 0), cB, voffB); PG8_STAGE(PG8_SA(0, 0), cA, voffA); PG8_STAGE(PG8_SB(0, 1), cB + hstep, voffB); PG8_STAGE(PG8_SA(0, 1), cA + hstep, voffA);
    if (wr == 1) PG8_BAR;
    PG8_WAIT_V(4); PG8_BAR;
    PG8_STAGE(PG8_SB(1, 0), cB + kstep, voffB); PG8_STAGE(PG8_SA(1, 0), cA + kstep, voffA); PG8_STAGE(PG8_SB(1, 1), cB + hstep + kstep, voffB);
    PG8_WAIT_V(6); PG8_BAR;
    PG8_STAMP();
    for (;;) {
        const bool has_next = S.next(ui + 1, nxt);
        const char* nA = has_next ? (const char*)g.A + (size_t)nxt.pm * tstep : cA; const char* nB = has_next ? (const char*)g.Bt + (size_t)nxt.pn * tstep : cB;
        for (int t = 0; t < nt; t += 2) {
            const bool last = (t == nt - 2);
            const char* a1 = cA + (size_t)(t + 1) * kstep;
            const char* a2 = last ? nA : cA + (size_t)(t + 2) * kstep; const char* b2 = last ? nB : cB + (size_t)(t + 2) * kstep;
            const char* a3 = a2 + kstep; const char* b3 = b2 + kstep;
            if (last && has_next) S.a_ready(nxt);
            PG8_LDB(B0, 0, 0); PG8_SCHED; PG8_LDA(At, 0, 0); PG8_STAGE(PG8_SA(1, 1), a1 + hstep, voffA);
            PG8_WAIT_L(8); PG8_BAR; PG8_WAIT_L(0); PG8_MMA(0, 0, At, B0); PG8_BAR; PG8_SCHED;
            PG8_LDB(B1, 0, 1); PG8_STAGE(PG8_SB(0, 0), b2, voffB);
            PG8_BAR; PG8_WAIT_L(0); PG8_MMA(0, 1, At, B1); PG8_BAR;
            PG8_LDA(At, 0, 1); PG8_STAGE(PG8_SA(0, 0), a2, voffA);
            PG8_BAR; PG8_WAIT_L(0); PG8_MMA(1, 0, At, B0); PG8_BAR; PG8_SCHED;
            PG8_STAGE(PG8_SB(0, 1), b2 + hstep, voffB);
            PG8_WAIT_V(6); PG8_BAR; PG8_MMA(1, 1, At, B1); PG8_BAR;
            PG8_LDB(B0, 1, 0); PG8_SCHED; PG8_LDA(At, 1, 0); PG8_STAGE(PG8_SA(0, 1), a2 + hstep, voffA);
            PG8_WAIT_L(8); PG8_BAR; PG8_WAIT_L(0); PG8_MMA(0, 0, At, B0); PG8_BAR; PG8_SCHED;
            PG8_LDB(B1, 1, 1); PG8_STAGE(PG8_SB(1, 0), b3, voffB);
            PG8_BAR; PG8_WAIT_L(0); PG8_MMA(0, 1, At, B1); PG8_BAR;
            PG8_LDA(At, 1, 1); PG8_STAGE(PG8_SA(1, 0), a3, voffA);
            PG8_BAR; PG8_WAIT_L(0); PG8_MMA(1, 0, At, B0); PG8_BAR; PG8_SCHED;
            PG8_STAGE(PG8_SB(1, 1), b3 + hstep, voffB);
            PG8_WAIT_V(6); PG8_BAR; PG8_MMA(1, 1, At, B1); PG8_BAR;
        }
        PG8_STAMP();
        if constexpr (!Epi::AFTER_DRAIN) { E(acc, cur, wr, wc, fr, fq); S.done(cur); }
        PG8_STAMP();
        if (!has_next) break;
#pragma unroll
        for (int a = 0; a < 2; ++a)
#pragma unroll
            for (int b = 0; b < 2; ++b)
#pragma unroll
                for (int m = 0; m < 4; ++m)
#pragma unroll
                    for (int n = 0; n < 2; ++n) acc[a][b][m][n] = (f32x4){0.f, 0.f, 0.f, 0.f};
        cur = nxt; cA = nA; cB = nB; ++ui;
    }
    PG8_WAIT_V(0);
    if (wr == 0) PG8_BAR;
    PG8_BAR;
    if constexpr (Epi::AFTER_DRAIN) { E.fused(acc, cur, wr, wc, fr, fq, lds, wid, lane); S.done(cur); }
    PG8_STAMP();
    if (STAMP && wid == 0) { stamps[lane] = lane < nts ? (((unsigned long long)(unsigned)ts_hi << 32) | (unsigned)ts_lo) : 0ull;
        if (lane == 62) stamps[62] = rt_entry; if (lane == 63) stamps[63] = (unsigned long long)wall_clock64(); }
#undef PG8_STAMP
#undef PG8_SA
#undef PG8_SB
#undef PG8_STAGE
#undef PG8_LDA
#undef PG8_LDB
#undef PG8_MMA
#undef PG8_WAIT_V
#undef PG8_WAIT_L
#undef PG8_BAR
#undef PG8_SCHED
}
}


DEV void inproj_store(const P& p, int l, int row, int ncol, f32x4 v, f32x4 lb) {
    unsigned char* ws = p.ws;
    const int pn = ncol >> 8, j = ncol & 255;
    if (pn < 6) {
        const int seg = j >> 6, c = pn * 64 + (j & 63);
        if (seg == 0) { st4bf((bf16_t*)(ws + O_HQ) + (size_t)row * 384 + c, (f32x4){siluf_(v[0]), siluf_(v[1]), siluf_(v[2]), siluf_(v[3])}); }
        else if (seg == 1) {
            f32x4 o;
#pragma unroll
            for (int r = 0; r < 4; ++r) o[r] = __logf(lb[r] + (1.0f - lb[r]) * sigmoidf_(v[r]));
            *(f32x4*)((float*)(ws + O_HG) + (size_t)row * 384 + c) = o;
        }
        else if (seg == 2) st4bf((bf16_t*)(ws + O_HV) + (size_t)row * 384 + c, v);
        else st4bf((bf16_t*)(ws + O_HZ) + (size_t)row * 384 + c, (f32x4){siluf_(v[0]), siluf_(v[1]), siluf_(v[2]), siluf_(v[3])});
    } else if (pn < 12) {
        const int h = pn - 6;
        if (j < 32) st4bf((bf16_t*)(ws + O_GQ) + (size_t)row * 384 + h * 64 + j, v * 0.17677669529663687f);
        else if (j < 64) st4bf((bf16_t*)(ws + O_GQ) + (size_t)row * 384 + h * 64 + j, v);
        else if (j < 128) st4bf((bf16_t*)(ws + O_GV) + (size_t)row * 384 + h * 64 + (j - 64), v);
        else if (j < 192) st4bf((bf16_t*)(ws + O_GZ) + (size_t)row * 384 + h * 64 + (j - 128), (f32x4){siluf_(v[0]), siluf_(v[1]), siluf_(v[2]), siluf_(v[3])});
        else if (j < 224) {
            f32x4 o;
#pragma unroll
            for (int r = 0; r < 4; ++r) { const float a = v[r] + lb[r]; o[r] = (fminf(a, 0.f) - __logf(1.0f + __expf(-fabsf(a)))) * (1.0f / 16.0f); }
            *(f32x4*)((float*)(ws + O_GR) + (size_t)row * 192 + h * 32 + (j - 192)) = o;
        }
    } else if (pn == 12) {
        if (row < TP) st4bf((bf16_t*)(ws + O_AS5) + ((size_t)(j >> 4) * 1024 + (row >> 4)) * 384 + (row & 15) * 16 + (j & 15), v);
        else if (row < MT) *(f32x4*)((float*)(ws + O_SUS) + (size_t)(row - TP) * 256 + j) = v;
    } else {
        st4bf((bf16_t*)(ws + O_SZ) + (size_t)row * 256 + j, (f32x4){siluf_(v[0]), siluf_(v[1]), siluf_(v[2]), siluf_(v[3])});
    }
}

DEV void st8bf(bf16_t* dst, f32x4 a, f32x4 b) { u32x4 w; w.x = cvt_pk(a[0], a[1]); w.y = cvt_pk(a[2], a[3]); w.z = cvt_pk(b[0], b[1]); w.w = cvt_pk(b[2], b[3]); *(u32x4*)dst = w; }
DEV f32x4 silu4(f32x4 v) { return (f32x4){siluf_(v[0]), siluf_(v[1]), siluf_(v[2]), siluf_(v[3])}; }

struct EpiIn {
    static constexpr bool PERM = true, AFTER_DRAIN = false;
    const P* p; int l;
    DEV void operator()(const f32x4 (&acc)[2][2][4][2], const pg8::Unit& u, int wr, int wc, int fr, int fq) const {
        unsigned char* ws = p->ws;
        const float* RSQ = (const float*)(ws + O_RSQ);
        const int pn = u.pn, rowb = u.pm * 256 + wr * 64 + fr;
float rr[2][4];
#pragma unroll
        for (int ai = 0; ai < 2; ++ai) {
            f32x4 q[4];
#pragma unroll
            for (int m = 0; m < 4; ++m) q[m] = *(const f32x4*)(RSQ + (rowb + ai * 128 + m * 16) * 16 + fq * 4);
#pragma unroll
            for (int m = 0; m < 4; ++m) {
                float ss = q[m][0] + q[m][1] + q[m][2] + q[m][3];
                ss += __shfl_xor(ss, 16); ss += __shfl_xor(ss, 32);
                rr[ai][m] = rsqrtf(ss * (1.0f / 1024.0f) + EPS);
            }
            asm volatile("" : "+v"(rr[ai][0]), "+v"(rr[ai][1]), "+v"(rr[ai][2]), "+v"(rr[ai][3]));
        }
#pragma unroll
        for (int ai = 0; ai < 2; ++ai) {
        float r[4];
#pragma unroll
        for (int m = 0; m < 4; ++m) r[m] = rr[ai][m];
#pragma unroll
        for (int bj = 0; bj < 2; ++bj) {
            const int j = bj * 128 + wc * 32 + 8 * fq;
            int kind; bf16_t* dstb = nullptr; float* dstf = nullptr; const float* exp_ = nullptr; int ld = 0;
            if (pn < 6) {
                const int seg = bj * 2 + (wc >> 1), c = pn * 64 + (j & 63); ld = 384;
                if (seg == 0) { kind = 1; dstb = (bf16_t*)(ws + O_HQ) + c; }
                else if (seg == 1) { kind = 2; dstf = (float*)(ws + O_HG) + c; exp_ = (const float*)(ws + O_LB) + l * 384 + c; }
                else if (seg == 2) { kind = 0; dstb = (bf16_t*)(ws + O_HV) + c; }
                else { kind = 1; dstb = (bf16_t*)(ws + O_HZ) + c; }
            } else if (pn < 12) {
                const int h = pn - 6; ld = 384;
                if (j < 32) { kind = 3; dstb = (bf16_t*)(ws + O_GQ) + h * 64 + j; }
                else if (j < 64) { kind = 0; dstb = (bf16_t*)(ws + O_GQ) + h * 64 + j; }
                else if (j < 128) { kind = 0; dstb = (bf16_t*)(ws + O_GV) + h * 64 + (j - 64); }
                else if (j < 192) { kind = 1; dstb = (bf16_t*)(ws + O_GZ) + h * 64 + (j - 128); }
                else if (j < 224) { kind = 4; dstf = (float*)(ws + O_GR) + h * 32 + (j - 192); ld = 192; exp_ = p->in[11] + l * 192 + h * 32 + (j - 192); }
                else kind = 6;
            } else if (pn == 12) { kind = 5; }
            else { kind = 1; dstb = (bf16_t*)(ws + O_SZ) + j; ld = 256; }
            f32x4 ex0 = (f32x4){0.f, 0.f, 0.f, 0.f}, ex1 = ex0;
            if (kind == 2 || kind == 4) { ex0 = *(const f32x4*)exp_; ex1 = *(const f32x4*)(exp_ + 4); }
#pragma unroll
                for (int m = 0; m < 4; ++m) {
                    const int row = rowb + ai * 128 + m * 16;
                    const f32x4 v0 = acc[ai][bj][m][0] * r[m], v1 = acc[ai][bj][m][1] * r[m];
                    if (kind == 0) st8bf(dstb + (size_t)row * ld, v0, v1);
                    else if (kind == 1) st8bf(dstb + (size_t)row * ld, silu4(v0), silu4(v1));
                    else if (kind == 3) st8bf(dstb + (size_t)row * ld, v0 * 0.17677669529663687f, v1 * 0.17677669529663687f);
                    else if (kind == 2) {
                        f32x4 o0, o1;
#pragma unroll
                        for (int e = 0; e < 4; ++e) { o0[e] = __logf(ex0[e] + (1.0f - ex0[e]) * sigmoidf_(v0[e])); o1[e] = __logf(ex1[e] + (1.0f - ex1[e]) * sigmoidf_(v1[e])); }
                        float* d = dstf + (size_t)row * ld; *(f32x4*)d = o0; *(f32x4*)(d + 4) = o1;
                    } else if (kind == 4) {
                        f32x4 o0, o1;
#pragma unroll
                        for (int e = 0; e < 4; ++e) {
                            const float a0 = v0[e] + ex0[e], a1 = v1[e] + ex1[e];
                            o0[e] = (fminf(a0, 0.f) - __logf(1.0f + __expf(-fabsf(a0)))) * (1.0f / 16.0f);
                            o1[e] = (fminf(a1, 0.f) - __logf(1.0f + __expf(-fabsf(a1)))) * (1.0f / 16.0f);
                        }
                        float* d = dstf + (size_t)row * ld; *(f32x4*)d = o0; *(f32x4*)(d + 4) = o1;
                    } else if (kind == 5) {
                        if (row < TP) st8bf((bf16_t*)(ws + O_AS5) + ((size_t)(j >> 4) * 1024 + (row >> 4)) * 384 + (row & 15) * 16 + (j & 15), v0, v1);
                        else if (row < MT) { float* d = (float*)(ws + O_SUS) + (size_t)(row - TP) * 256 + j; *(f32x4*)d = v0; *(f32x4*)(d + 4) = v1; }
                    }
                }
        }
        }
    }
};

DEV void phase_inproj(const Ctx cx, const P& p, int l, unsigned char* lds) {
    pg8::Gemm g{(const bf16_t*)(p.ws + O_AX), (const bf16_t*)(p.ws + O_BTIN) + (size_t)l * NPERM * D, MPAD, NPERM, D};
    pg8::StaticOrder S; S.init(MPAD, NPERM, cx.G, cx.bid);
    EpiIn E{&p, l};
    pg8::gemm_phase<EpiIn, pg8::StaticOrder>(cx.tid, (PG8_LAS unsigned char*)lds, g, S, E, nullptr);
    if (l == 0 && cx.G == 256 && cx.bid >= 142) phase_prep(cx, p, lds, 1, cx.bid - 142, 114);
}

template <int DK, int MODE>
DEV void chunk_item(const Ctx cx, const P& p, int l, int item, unsigned char* lds) {
    constexpr bool GLA = (DK == 32);
    constexpr int BSTR = DK + 4, KS = DK + 8, SS = 72, EPT = DK / 8;
    float* Bs = (float*)lds; float* Tot = Bs + 65 * BSTR; float* Rb = Tot + 16 * DK; float* W2s = Rb + 1024; float* b2s = W2s + 512; float* Psq = b2s + 32;
    bf16_t* Qh = (bf16_t*)(Psq + 128); bf16_t* Qt = Qh + 64 * KS; bf16_t* Kt = Qt + 64 * KS; bf16_t* ST = Kt + 4 * 64 * KS;
    bf16_t* VT = ST + 64 * KS; bf16_t* Att = VT + 64 * SS; bf16_t* KhT = Att + 64 * SS;
    const int tid = cx.tid, lane = tid & 63, wid = tid >> 6, fr = lane & 15, fq = lane >> 4;
    const int bh = item >> 5, c = item & 31, b = bh / 6, h = bh - b * 6, tok0 = b * 2048 + c * 64;
    unsigned char* ws = p.ws;
    bf16_t* DS = (bf16_t*)(ws + (GLA ? O_DSG : O_DSH)) + (size_t)item * 64 * DK;
#define NTL(T, ptr) __builtin_nontemporal_load((const T*)(ptr))
    const int t3 = tid >> 3, kp3 = tid & 7, k03 = kp3 * EPT; const size_t tok3 = (size_t)tok0 + t3;
    f32x4 pg0 = (f32x4){0.f, 0.f, 0.f, 0.f}, pg1 = pg0;
    u32x4 pq4 = (u32x4){0u, 0u, 0u, 0u}, pds4 = pq4; u32x2 pq2 = (u32x2){0u, 0u}, pk2 = pq2, pds2 = pq2;
    if (!GLA) {
        const float* g = (const float*)(ws + O_HG) + tok3 * 384 + h * 64 + kp3 * 8;
        pg0 = NTL(f32x4, g); pg1 = NTL(f32x4, g + 4);
        pq4 = NTL(u32x4, (const bf16_t*)(ws + O_HQ) + tok3 * 384 + h * 64 + k03);
        if (MODE == 1) pds4 = NTL(u32x4, DS + t3 * DK + k03);
    } else {
        pg0 = NTL(f32x4, (const float*)(ws + O_GR) + tok3 * 192 + h * 32 + kp3 * 4);
        pq2 = NTL(u32x2, (const bf16_t*)(ws + O_GQ) + tok3 * 384 + h * 64 + k03);
        pk2 = NTL(u32x2, (const bf16_t*)(ws + O_GQ) + tok3 * 384 + h * 64 + 32 + k03);
        if (MODE == 1) pds2 = NTL(u32x2, DS + t3 * DK + k03);
    }
    const u32x4 pvw = NTL(u32x4, (const bf16_t*)(ws + (GLA ? O_GV : O_HV)) + tok3 * 384 + h * 64 + kp3 * 8);
    f32x4 gnv[2] = {pg0, pg0}; u32x4 pz4 = pq4;
    if (MODE == 1) {
        const int I6 = wid & 3, vh6 = wid >> 2, t6 = 16 * I6 + fr;
#pragma unroll
        for (int ni = 0; ni < 2; ++ni) gnv[ni] = *(const f32x4*)(p.in[GLA ? 12 : 9] + l * 384 + h * 64 + vh6 * 32 + 8 * fq + 4 * ni);
        pz4 = NTL(u32x4, (const bf16_t*)(ws + (GLA ? O_GZ : O_HZ)) + ((size_t)tok0 + t6) * 384 + h * 64 + vh6 * 32 + 8 * fq);
    }
#undef NTL
    lds_barrier();
    if (!GLA) {
        *(f32x4*)(Bs + (t3 + 1) * BSTR + kp3 * 8) = pg0; *(f32x4*)(Bs + (t3 + 1) * BSTR + kp3 * 8 + 4) = pg1;
    } else {
        *(f32x4*)(Bs + (t3 + 1) * BSTR + kp3 * 4) = pg0;
    }
    if (tid < DK) Bs[tid] = 0.f;
    lds_barrier();
    {
        constexpr int NSEG = NTHR / DK, SEGLEN = 64 / NSEG;
        const int k = tid % DK, seg = tid / DK, t0 = seg * SEGLEN;
        float run = 0.f;
#pragma unroll
        for (int i = 0; i < SEGLEN; ++i) { run += Bs[(t0 + i + 1) * BSTR + k]; Bs[(t0 + i + 1) * BSTR + k] = run; }
        Tot[seg * DK + k] = run;
        lds_barrier();
        float off = 0.f;
        for (int s = 0; s < seg; ++s) off += Tot[s * DK + k];
#pragma unroll
        for (int i = 0; i < SEGLEN; ++i) Bs[(t0 + i + 1) * BSTR + k] += off;
    }
    lds_barrier();
    {
        const int t = tid >> 3, kp = tid & 7, k0 = kp * EPT, I = t >> 4;
        float qv[EPT], kv[EPT], bt[EPT];
#pragma unroll
        for (int e = 0; e < EPT; ++e) bt[e] = Bs[(t + 1) * BSTR + k0 + e];
        if (!GLA) {
            const u32x4 qw = pq4;
            qv[0] = bflo(qw.x); qv[1] = bfhi(qw.x); qv[2] = bflo(qw.y); qv[3] = bfhi(qw.y);
            if (EPT == 8) { qv[EPT - 4] = bflo(qw.z); qv[EPT - 3] = bfhi(qw.z); qv[EPT - 2] = bflo(qw.w); qv[EPT - 1] = bfhi(qw.w); }
#pragma unroll
            for (int e = 0; e < EPT; ++e) kv[e] = 1.0f - __expf(bt[e] - Bs[t * BSTR + k0 + e]);
        } else {
            const u32x2 qw = pq2, kw = pk2;
            qv[0] = bflo(qw.x); qv[1] = bfhi(qw.x); qv[2] = bflo(qw.y); qv[3] = bfhi(qw.y);
            kv[0] = bflo(kw.x); kv[1] = bfhi(kw.x); kv[2] = bflo(kw.y); kv[3] = bfhi(kw.y);
        }
        {
            const u32x4 vw = rot8h(pvw, kp);
            const unsigned w4[4] = {vw.x, vw.y, vw.z, vw.w};
#pragma unroll
            for (int i = 0; i < 8; ++i) { const int vv = kp * 8 + ((i + kp) & 7); VT[(MODE == 1 ? vslot(vv) : vv) * SS + t] = (bf16_t)((i & 1) ? (w4[i >> 1] >> 16) : (w4[i >> 1] & 0xffffu)); }
        }
        if (MODE == 0) {
#pragma unroll
            for (int e = 0; e < EPT; ++e) kv[e] *= __expf(Bs[64 * BSTR + k0 + e] - bt[e]);
            if (EPT == 8) {
                u32x4 kw8; kw8.x = cvt_pk(kv[0], kv[1]); kw8.y = cvt_pk(kv[2], kv[3]); kw8.z = cvt_pk(kv[EPT - 4], kv[EPT - 3]); kw8.w = cvt_pk(kv[EPT - 2], kv[EPT - 1]);
                kw8 = rot8h(kw8, kp);
                const unsigned w4[4] = {kw8.x, kw8.y, kw8.z, kw8.w};
#pragma unroll
                for (int i = 0; i < 8; ++i) KhT[(kp * 8 + ((i + kp) & 7)) * SS + t] = (bf16_t)((i & 1) ? (w4[i >> 1] >> 16) : (w4[i >> 1] & 0xffffu));
            } else {
                u32x2 kw4; kw4.x = cvt_pk(kv[0], kv[1]); kw4.y = cvt_pk(kv[2], kv[3]);
                const int rr = kp >> 1;
                kw4 = rot4h(kw4, rr);
                const unsigned w2[2] = {kw4.x, kw4.y};
#pragma unroll
                for (int i = 0; i < 4; ++i) KhT[(kp * 4 + ((i + rr) & 3)) * SS + t] = (bf16_t)((i & 1) ? (w2[i >> 1] >> 16) : (w2[i >> 1] & 0xffffu));
            }
            if (tid < DK) ((float*)(ws + (GLA ? O_DDG : O_DDH)))[(size_t)item * DK + tid] = __expf(Bs[64 * BSTR + tid]);
        } else {
            float o1[EPT], o2[EPT];
#pragma unroll
            for (int e = 0; e < EPT; ++e) { o1[e] = qv[e] * __expf(bt[e]); o2[e] = qv[e] * __expf(bt[e] - Bs[(16 * I) * BSTR + k0 + e]); }
#pragma unroll
            for (int e = 0; e < EPT; e += 4) { st4bf(Qh + t * KS + k0 + e, (f32x4){o1[e], o1[e + 1], o1[e + 2], o1[e + 3]}); st4bf(Qt + t * KS + k0 + e, (f32x4){o2[e], o2[e + 1], o2[e + 2], o2[e + 3]}); }
            for (int I2 = I; I2 < 4; ++I2) {
#pragma unroll
                for (int e = 0; e < EPT; ++e) o1[e] = kv[e] * expc(Bs[(16 * I2) * BSTR + k0 + e] - bt[e]);
#pragma unroll
                for (int e = 0; e < EPT; e += 4) st4bf(Kt + (I2 * 64 + t) * KS + k0 + e, (f32x4){o1[e], o1[e + 1], o1[e + 2], o1[e + 3]});
            }
            if (EPT == 8) *(u32x4*)(ST + vslot(t) * KS + k0) = pds4;
            else *(u32x2*)(ST + vslot(t) * KS + k0) = pds2;
        }
    }
    lds_barrier();
    if (MODE == 0) {
        const int mi = wid & 3;
#pragma unroll
        for (int x = 0; x < DK / 32; ++x) {
            const int nj = (wid >> 2) * (DK / 32) + x;
            f32x4 acc = (f32x4){0.f, 0.f, 0.f, 0.f};
#pragma unroll
            for (int kk = 0; kk < 2; ++kk) {
                const bf16x8 a = *(const bf16x8*)(VT + (16 * mi + fr) * SS + kk * 32 + fq * 8);
                const bf16x8 bq = *(const bf16x8*)(KhT + (16 * nj + fr) * SS + kk * 32 + fq * 8);
                acc = __builtin_amdgcn_mfma_f32_16x16x32_bf16(bq, a, acc, 0, 0, 0);
            }
            st4bf(DS + (16 * mi + fr) * DK + 16 * nj + 4 * fq, acc);
        }
        return;
    }
#pragma unroll
    for (int rep = 0; rep < 2; ++rep) {
        const int idx = wid + rep * 8;
        if (idx < 10) {
            const int I = idx >= 6 ? 3 : (idx >= 3 ? 2 : (idx >= 1 ? 1 : 0)), J = idx - (I * (I + 1)) / 2;
            f32x4 acc = (f32x4){0.f, 0.f, 0.f, 0.f};
#pragma unroll
            for (int kk = 0; kk < DK / 32; ++kk) {
                const bf16x8 a = *(const bf16x8*)(Qt + (16 * I + fr) * KS + kk * 32 + fq * 8);
                const bf16x8 bq = *(const bf16x8*)(Kt + (I * 64 + 16 * J + fr) * KS + kk * 32 + fq * 8);
                acc = __builtin_amdgcn_mfma_f32_16x16x32_bf16(bq, a, acc, 0, 0, 0);
            }
            if (I == J) {
#pragma unroll
                for (int r = 0; r < 4; ++r) if (4 * fq + r > fr) acc[r] = 0.f;
            }
            st4bf(Att + (16 * I + fr) * SS + 16 * J + 4 * fq, acc);
        } else {
            const int z = idx - 10, I = z < 3 ? 0 : (z < 5 ? 1 : 2), J = z < 3 ? z + 1 : (z < 5 ? z - 1 : 3);
            *(u32x2*)(Att + (16 * I + fr) * SS + 16 * J + 4 * fq) = (u32x2){0u, 0u};
        }
    }
    lds_barrier();
    const int I = wid & 3, vh = wid >> 2;
    f32x4 o[2];
#pragma unroll
    for (int ni = 0; ni < 2; ++ni) {
        f32x4 acc = (f32x4){0.f, 0.f, 0.f, 0.f};
#pragma unroll
        for (int kk = 0; kk < DK / 32; ++kk) {
            const bf16x8 a = *(const bf16x8*)(Qh + (16 * I + fr) * KS + kk * 32 + fq * 8);
            const bf16x8 bq = *(const bf16x8*)(ST + (vh * 32 + ni * 16 + fr) * KS + kk * 32 + fq * 8);
            acc = __builtin_amdgcn_mfma_f32_16x16x32_bf16(bq, a, acc, 0, 0, 0);
        }
#pragma unroll
        for (int kk = 0; kk < 2; ++kk) {
            const bf16x8 a = *(const bf16x8*)(Att + (16 * I + fr) * SS + kk * 32 + fq * 8);
            const bf16x8 bq = *(const bf16x8*)(VT + (vh * 32 + ni * 16 + fr) * SS + kk * 32 + fq * 8);
            acc = __builtin_amdgcn_mfma_f32_16x16x32_bf16(bq, a, acc, 0, 0, 0);
        }
        o[ni] = acc;
    }
    float ss = 0.f;
#pragma unroll
    for (int ni = 0; ni < 2; ++ni) ss += o[ni][0] * o[ni][0] + o[ni][1] * o[ni][1] + o[ni][2] * o[ni][2] + o[ni][3] * o[ni][3];
    ss += __shfl_xor(ss, 16); ss += __shfl_xor(ss, 32);
    const int t = 16 * I + fr;
    if (fq == 0) Psq[t * 2 + vh] = ss;
    lds_barrier();
    const float sc = rsqrtf((Psq[t * 2] + Psq[t * 2 + 1]) * (1.0f / 64.0f) + EPS);
    bf16_t* MIX = (bf16_t*)(ws + O_MIX) + ((size_t)tok0 + t) * 1024 + (GLA ? 384 : 0) + h * 64;
    {
        const int v0 = vh * 32 + 8 * fq;
        const f32x4 g0 = gnv[0], g1 = gnv[1]; const u32x4 zw = pz4;
        u32x4 w;
        w.x = cvt_pk(o[0][0] * sc * g0[0] * bflo(zw.x), o[0][1] * sc * g0[1] * bfhi(zw.x)); w.y = cvt_pk(o[0][2] * sc * g0[2] * bflo(zw.y), o[0][3] * sc * g0[3] * bfhi(zw.y));
        w.z = cvt_pk(o[1][0] * sc * g1[0] * bflo(zw.z), o[1][1] * sc * g1[1] * bfhi(zw.z)); w.w = cvt_pk(o[1][2] * sc * g1[2] * bflo(zw.w), o[1][3] * sc * g1[3] * bfhi(zw.w));
        *(u32x4*)(MIX + v0) = w;
    }
}

template <int DK>
DEV void chunk_item0(const Ctx cx, const P& p, int l, int item, unsigned char* lds) {
    constexpr bool GLA = (DK == 32);
    constexpr int SS = 72, NSEG = NTHR / DK, SL = 64 / NSEG;
    float* Tot = (float*)lds;
    bf16_t* VT = (bf16_t*)(Tot + NSEG * DK);
    bf16_t* KhT = VT + 64 * SS;
    const int tid = cx.tid, lane = tid & 63, wid = tid >> 6, fr = lane & 15, fq = lane >> 4;
    const int bh = item >> 5, c = item & 31, b = bh / 6, h = bh - b * 6, tok0 = b * 2048 + c * 64;
    unsigned char* ws = p.ws;
    bf16_t* DS = (bf16_t*)(ws + (GLA ? O_DSG : O_DSH)) + (size_t)item * 64 * DK;
    const int k = tid % DK, seg = tid / DK, t0 = seg * SL;
    float g[SL]; bf16_t kr[SL];
#pragma unroll
    for (int i = 0; i < SL; ++i) {
        const size_t tok = (size_t)tok0 + t0 + i;
        if (!GLA) g[i] = ((const float*)(ws + O_HG))[tok * 384 + h * 64 + k];
        else { g[i] = ((const float*)(ws + O_GR))[tok * 192 + h * 32 + k]; kr[i] = ((const bf16_t*)(ws + O_GQ))[tok * 384 + h * 64 + 32 + k]; }
    }
    const int v = tid & 63, vs = tid >> 6;
    bf16_t vr[8];
#pragma unroll
    for (int i = 0; i < 8; ++i) vr[i] = ((const bf16_t*)(ws + (GLA ? O_GV : O_HV)))[((size_t)tok0 + vs * 8 + i) * 384 + h * 64 + v];
    float bt[SL]; float run = 0.f;
#pragma unroll
    for (int i = 0; i < SL; ++i) { run += g[i]; bt[i] = run; }
    lds_barrier();
    Tot[seg * DK + k] = run;
    { u32x4 w; w.x = (unsigned)vr[0] | ((unsigned)vr[1] << 16); w.y = (unsigned)vr[2] | ((unsigned)vr[3] << 16); w.z = (unsigned)vr[4] | ((unsigned)vr[5] << 16); w.w = (unsigned)vr[6] | ((unsigned)vr[7] << 16);
      *(u32x4*)(VT + v * SS + vs * 8) = w; }
    lds_barrier();
    float off = 0.f, tot = 0.f;
#pragma unroll
    for (int s2 = 0; s2 < NSEG; ++s2) { const float x = Tot[s2 * DK + k]; tot += x; if (s2 < seg) off += x; }
    float kh[SL];
#pragma unroll
    for (int i = 0; i < SL; ++i) {
        const float kv = GLA ? bf2f(kr[i]) : 1.0f - __expf(g[i]);
        kh[i] = kv * __expf(tot - (bt[i] + off));
    }
    if (SL == 8) { u32x4 w; w.x = cvt_pk(kh[0], kh[1]); w.y = cvt_pk(kh[2], kh[3]); w.z = cvt_pk(kh[SL - 4], kh[SL - 3]); w.w = cvt_pk(kh[SL - 2], kh[SL - 1]); *(u32x4*)(KhT + k * SS + t0) = w; }
    else { u32x2 w; w.x = cvt_pk(kh[0], kh[1]); w.y = cvt_pk(kh[2], kh[3]); *(u32x2*)(KhT + k * SS + t0) = w; }
    if (seg == 0) ((float*)(ws + (GLA ? O_DDG : O_DDH)))[(size_t)item * DK + k] = __expf(tot);
    lds_barrier();
    const int mi = wid & 3;
#pragma unroll
    for (int x = 0; x < DK / 32; ++x) {
        const int nj = (wid >> 2) * (DK / 32) + x;
        f32x4 acc = (f32x4){0.f, 0.f, 0.f, 0.f};
#pragma unroll
        for (int kk = 0; kk < 2; ++kk) {
            const bf16x8 a = *(const bf16x8*)(VT + (16 * mi + fr) * SS + kk * 32 + fq * 8);
            const bf16x8 bq = *(const bf16x8*)(KhT + (16 * nj + fr) * SS + kk * 32 + fq * 8);
            acc = __builtin_amdgcn_mfma_f32_16x16x32_bf16(bq, a, acc, 0, 0, 0);
        }
        st4bf(DS + (16 * mi + fr) * DK + 16 * nj + 4 * fq, acc);
    }
}

DEV void phase_b1(const Ctx cx0, const P& p, int l, unsigned char* lds) {
    for (int it = cx0.bid; it < 3200; it += cx0.G) {
        const Ctx cx = relaunder(cx0);
        const int tid = cx.tid, lane = tid & 63, wid = tid >> 6, wr = wid >> 1, wc = wid & 1, fr = lane & 15, fq = lane >> 4;
#ifndef B1MASK
#define B1MASK 7
#endif
        if (it < 1536) { if (B1MASK & 1) chunk_item0<64>(cx, p, l, it, lds); }
        else if (it < 3072) { if (B1MASK & 2) chunk_item0<32>(cx, p, l, it - 1536, lds); }
        else if (B1MASK & 4) {
            const int it0 = it - 3072, it2 = (cx.G == 256) ? (((it0 & 7) << 4) | (it0 >> 3)) : it0;
            const int g = it2 >> 3, rt = it2 & 7;
            f32x4 acc[2][4];
            gemm128<2>(cx, (const bf16_t*)(p.ws + O_AS5) + (size_t)g * 1024 * 384, 384, (const bf16_t*)(p.ws + O_BTS5S) + (size_t)(l * 16 + g) * 128 * 256, 256, rt * 128, 0, lds, acc);
            float* S5S = (float*)(p.ws + O_S5S);
#pragma unroll
            for (int mi = 0; mi < 2; ++mi)
#pragma unroll
                for (int ni = 0; ni < 4; ++ni) {
                    const int ch = rt * 128 + wr * 32 + mi * 16 + fr, n = wc * 64 + ni * 16 + 4 * fq;
                    *(f32x4*)(S5S + ((size_t)g * 1024 + ch) * 128 + n) = acc[mi][ni];
                }
        }
    }
}

DEV void glu_tile(const Ctx cx, const P& p, int l, const bf16_t* Y, int rowbase, int rt, int ct, unsigned char* lds);
DEV void phase_b3(const Ctx cx0, const P& p, int l, unsigned char* lds) {
    const bool rebal = (cx0.G == 256);
    if (rebal && cx0.bid >= 2 && cx0.bid < 6) {
        const Ctx cx = relaunder(cx0);
        const int e = cx0.bid - 2, it = (e & 1) + 256 * (10 + (e >> 1));
        chunk_item<32, 1>(cx, p, l, it - 1536, lds);
    }
    for (int it = cx0.bid; it < 3330; it += cx0.G) {
        if (rebal && cx0.bid < 2 && it >= 2560 && it < 3072) continue;
        const Ctx cx = relaunder(cx0);
        const int tid = cx.tid, lane = tid & 63, wid = tid >> 6, wr = wid >> 1, wc = wid & 1, fr = lane & 15, fq = lane >> 4;
        if (it >= 3328) { glu_tile(cx, p, l, (const bf16_t*)(p.ws + O_YGS), TP, 0, it - 3328, lds); continue; }
        if (it < 1536) chunk_item<64, 1>(cx, p, l, it, lds);
        else if (it < 3072) chunk_item<32, 1>(cx, p, l, it - 1536, lds);
        else {
            const int it0 = it - 3072, it2 = (cx.G == 256) ? (((it0 & 7) << 5) | (it0 >> 3)) : it0;
            const int g = it2 >> 4, rt = (it2 & 15) >> 1, ct = it2 & 1;
            f32x4 acc[2][4];
            gemm128<3>(cx, (const bf16_t*)(p.ws + O_AS5) + (size_t)g * 1024 * 384, 384, (const bf16_t*)(p.ws + O_BTS5Y) + (size_t)(l * 16 + g) * 256 * 384, 384, rt * 128, ct * 128, lds, acc);
            bf16_t* YG = (bf16_t*)(p.ws + O_S5S);
#pragma unroll
            for (int mi = 0; mi < 2; ++mi)
#pragma unroll
                for (int ni = 0; ni < 4; ++ni) {
                    const int ch = rt * 128 + wr * 32 + mi * 16 + fr, n = ct * 128 + wc * 64 + ni * 16 + 4 * fq, i = n >> 4, c = n & 15;
                    const f32x4 a = acc[mi][ni];
                    st4bf(YG + ((size_t)ch * 16 + i) * 256 + g * 16 + c, (f32x4){geluf_(a[0]), geluf_(a[1]), geluf_(a[2]), geluf_(a[3])});
                }
        }
    }
}

DEV void outproj_tile128(const Ctx cx, const P& p, int l, int ct, int kc, unsigned char* lds);
DEV void glu_tile(const Ctx cx, const P& p, int l, const bf16_t* Y, int rowbase, int rt, int ct, unsigned char* lds) {
    const int tid = cx.tid, lane = tid & 63, wid = tid >> 6, wr = wid >> 1, wc = wid & 1, fr = lane & 15, fq = lane >> 4;
    f32x4 bg[4]; u32x2 yw[2][4], zw[2][4];
#pragma unroll
    for (int ni = 0; ni < 4; ++ni) bg[ni] = *(const f32x4*)(p.in[22] + l * 256 + ct * 128 + wc * 64 + ni * 16 + 4 * fq);
#pragma unroll
    for (int mi = 0; mi < 2; ++mi)
#pragma unroll
        for (int ni = 0; ni < 4; ++ni) {
            const int yr = rt * 128 + wr * 32 + mi * 16 + fr, n = ct * 128 + wc * 64 + ni * 16 + 4 * fq;
            yw[mi][ni] = __builtin_nontemporal_load((const u32x2*)(Y + (size_t)yr * 256 + n));
            zw[mi][ni] = __builtin_nontemporal_load((const u32x2*)((const bf16_t*)(p.ws + O_SZ) + ((size_t)rowbase + yr) * 256 + n));
        }
    f32x4 acc[2][4];
    gemm128<2>(cx, Y, 256, (const bf16_t*)(p.ws + O_BTGLU) + (size_t)l * 65536, 256, rt * 128, ct * 128, lds, acc);
#pragma unroll
    for (int mi = 0; mi < 2; ++mi)
#pragma unroll
        for (int ni = 0; ni < 4; ++ni) {
            const int yr = rt * 128 + wr * 32 + mi * 16 + fr, n = ct * 128 + wc * 64 + ni * 16 + 4 * fq; const size_t tok = (size_t)rowbase + yr;
            const f32x4 a = acc[mi][ni] + bg[ni];
            const u32x2 y2 = yw[mi][ni], z2 = zw[mi][ni];
            f32x4 r; r[0] = bflo(y2.x) * sigmoidf_(a[0]) * bflo(z2.x); r[1] = bfhi(y2.x) * sigmoidf_(a[1]) * bfhi(z2.x);
            r[2] = bflo(y2.y) * sigmoidf_(a[2]) * bflo(z2.y); r[3] = bfhi(y2.y) * sigmoidf_(a[3]) * bfhi(z2.y);
            st4bf((bf16_t*)(p.ws + O_MIX) + tok * 1024 + 768 + n, r);
        }
}

DEV void phase_b4(const Ctx cx0, const P& p, int l, unsigned char* lds) {
    for (int it = cx0.bid; it < 288; it += cx0.G) {
        const Ctx cx = relaunder(cx0);
        if (it >= 256) outproj_tile128(cx, p, l, (it - 256) & 7, (it - 256) >> 3, lds);
        else { const int is = (cx0.G == 256) ? (((it & 7) << 5) | (it >> 3)) : it; glu_tile(cx, p, l, (const bf16_t*)(p.ws + O_S5S), 0, is >> 1, is & 1, lds); }
    }
}

template <int DK>
DEV void scan_item(const Ctx cx, const P& p, int l, int wi) {
    constexpr bool GLA = (DK == 32);
    constexpr int WPB = (64 * DK) / 256;
    const int lane = cx.tid & 63;
    const int bh = wi / WPB, sub = wi - bh * WPB, e0 = sub * 256 + lane * 4, v = e0 / DK, k = e0 % DK;
    const float* DD = (const float*)(p.ws + (GLA ? O_DDG : O_DDH)) + (size_t)bh * 32 * DK + k;
    bf16_t* DS = (bf16_t*)(p.ws + (GLA ? O_DSG : O_DSH)) + (size_t)bh * 32 * 64 * DK + e0;
    f32x4 S = (f32x4){0.f, 0.f, 0.f, 0.f};
    for (int c0 = 0; c0 < 32; c0 += 8) {
        f32x4 d[8]; u32x2 w[8];
#pragma unroll
        for (int i = 0; i < 8; ++i) { d[i] = __builtin_nontemporal_load((const f32x4*)(DD + (size_t)(c0 + i) * DK)); w[i] = *(const u32x2*)(DS + (size_t)(c0 + i) * 64 * DK); }
#pragma unroll
        for (int i = 0; i < 8; ++i) {
            st4bf(DS + (size_t)(c0 + i) * 64 * DK, S);
            S[0] = d[i][0] * S[0] + bflo(w[i].x); S[1] = d[i][1] * S[1] + bfhi(w[i].x); S[2] = d[i][2] * S[2] + bflo(w[i].y); S[3] = d[i][3] * S[3] + bfhi(w[i].y);
        }
    }
    float* o = p.out + (GLA ? OUT_GP : OUT_HP) + ((size_t)l * 48 + bh) * DK * 64;
#pragma unroll
    for (int e = 0; e < 4; ++e) o[(k + e) * 64 + v] = S[e];
}

DEV void s5_scan_item(const Ctx cx, const P& p, int l, int wi) {
    const int lane = cx.tid & 63, b = wi >> 4, g = wi & 15;
    const float* A16 = (const float*)(p.ws + O_A16) + ((l * 16 + g) * 64 + lane) * 2;
    const float ar = A16[0], ai = A16[1];
    const float* S5S = (const float*)(p.ws + O_S5S) + ((size_t)g * 1024 + b * 128) * 128 + lane;
    bf16_t* AS5 = (bf16_t*)(p.ws + O_AS5) + ((size_t)g * 1024 + b * 128) * 384 + 256 + lane;
    float xr = 0.f, xi = 0.f;
    float sr[16], si[16], tr[16], ti[16];
#pragma unroll
    for (int i = 0; i < 16; ++i) { sr[i] = __builtin_nontemporal_load(S5S + i * 128); si[i] = __builtin_nontemporal_load(S5S + i * 128 + 64); }
    for (int c0 = 0; c0 < 128; c0 += 16) {
        if (c0 + 16 < 128) {
#pragma unroll
            for (int i = 0; i < 16; ++i) { tr[i] = __builtin_nontemporal_load(S5S + (c0 + 16 + i) * 128); ti[i] = __builtin_nontemporal_load(S5S + (c0 + 16 + i) * 128 + 64); }
        }
#pragma unroll
        for (int i = 0; i < 16; ++i) {
            AS5[(size_t)(c0 + i) * 384] = f2bf(xr); AS5[(size_t)(c0 + i) * 384 + 64] = f2bf(xi);
            const float nr = ar * xr - ai * xi + sr[i], ni = ar * xi + ai * xr + si[i];
            xr = nr; xi = ni;
        }
#pragma unroll
        for (int i = 0; i < 16; ++i) { sr[i] = tr[i]; si[i] = ti[i]; }
    }
    p.out[OUT_RP + ((size_t)(l * 8 + b) * 16 + g) * 64 + lane] = xr;
    p.out[OUT_IP + ((size_t)(l * 8 + b) * 16 + g) * 64 + lane] = xi;
}

template <int DK>
DEV void sample_rec_item(const Ctx cx, const P& p, int l, int wi) {
    constexpr bool GLA = (DK == 32);
    const int lane = cx.tid & 63, j = wi / 6, h = wi - j * 6; const size_t row = TP + j;
    unsigned char* ws = p.ws;
    float fk, kk_, qk;
    if (!GLA) {
        const float g = ((const float*)(ws + O_HG))[row * 384 + h * 64 + lane];
        fk = __expf(g); kk_ = 1.0f - fk; qk = bf2f(((const bf16_t*)(ws + O_HQ))[row * 384 + h * 64 + lane]);
    } else {
        const int k = lane & 31;
        fk = __expf(((const float*)(ws + O_GR))[row * 192 + h * 32 + k]);
        kk_ = bf2f(((const bf16_t*)(ws + O_GQ))[row * 384 + h * 64 + 32 + k]); qk = bf2f(((const bf16_t*)(ws + O_GQ))[row * 384 + h * 64 + k]);
    }
    const float vv = bf2f(((const bf16_t*)(ws + (GLA ? O_GV : O_HV)))[row * 384 + h * 64 + lane]);
    const float* S0 = p.in[GLA ? 3 : 2] + (((size_t)l * 128 + j) * 6 + h) * DK * 64;
    float* S1 = p.out + (GLA ? OUT_GS : OUT_HS) + (((size_t)l * 128 + j) * 6 + h) * DK * 64;
    float o = 0.f;
    const float gn = p.in[GLA ? 12 : 9][l * 384 + h * 64 + lane];
    const float z = bf2f(((const bf16_t*)(ws + (GLA ? O_GZ : O_HZ)))[row * 384 + h * 64 + lane]);
    for (int k0 = 0; k0 < DK; k0 += 16) {
        float s0[16];
#pragma unroll
        for (int i = 0; i < 16; ++i) s0[i] = __builtin_nontemporal_load(S0 + (k0 + i) * 64 + lane);
#pragma unroll
        for (int i = 0; i < 16; ++i) {
            const int k = k0 + i;
            const float f = __shfl(fk, k), kq = __shfl(kk_, k), qq = __shfl(qk, k);
            const float sn = f * s0[i] + kq * vv;
            S1[k * 64 + lane] = sn; o += qq * sn;
        }
    }
    const float ss = wave_sum(o * o), sc = rsqrtf(ss * (1.0f / 64.0f) + EPS);
    ((bf16_t*)(ws + O_MIX))[row * 1024 + (GLA ? 384 : 0) + h * 64 + lane] = f2bf(o * sc * gn * z);
}

DEV void sample_s5_item(const Ctx cx, const P& p, int l, int wi) {
    const int lane = cx.tid & 63, j = wi >> 4, g = wi & 15, lg = l * 16 + g;
    unsigned char* ws = p.ws;
    const float* u = (const float*)(ws + O_SUS) + (size_t)j * 256 + g * 16;
    const float* AB = (const float*)(ws + O_ABAR) + (lg * 64 + lane) * 2;
    const float* BB = (const float*)(ws + O_BB) + ((size_t)(lg * 64 + lane) * 16) * 2;
    const size_t so = (((size_t)l * 128 + j) * 16 + g) * 64 + lane;
    const float x0r = p.in[4][so], x0i = p.in[5][so];
    float cr[16], ci[16];
#pragma unroll
    for (int c = 0; c < 16; ++c) { cr[c] = p.in[17][((size_t)lg * 16 + c) * 64 + lane]; ci[c] = p.in[18][((size_t)lg * 16 + c) * 64 + lane]; }
    float xr = AB[0] * x0r - AB[1] * x0i, xi = AB[0] * x0i + AB[1] * x0r;
#pragma unroll
    for (int c = 0; c < 16; ++c) { const float uu = u[c]; xr += BB[c * 2] * uu; xi += BB[c * 2 + 1] * uu; }
    const float du = (lane < 16) ? p.in[19][l * 256 + g * 16 + lane] * u[lane] : 0.f;
    p.out[OUT_RS + so] = xr; p.out[OUT_IS + so] = xi;
    float mine = 0.f;
#pragma unroll
    for (int c = 0; c < 16; ++c) {
        const float part = wave_sum(cr[c] * xr - ci[c] * xi);
        if (lane == c) mine = part;
    }
    if (lane < 16) {
        const float y = mine + du;
        ((bf16_t*)(ws + O_YGS))[(size_t)j * 256 + g * 16 + lane] = f2bf(geluf_(y));
    }
}

DEV void phase_b2(const Ctx cx, const P& p, int l, unsigned char* lds) {
    const int wid = cx.tid >> 6;
    if (cx.G >= 256) {
        if (wid == 0 && cx.bid < 128) { s5_scan_item(cx, p, l, cx.bid); return; }
        const int rank = (wid == 0) ? cx.bid - 128 : 128 + (wid - 1) * cx.G + cx.bid, nw = cx.G * 8 - 128;
        for (int it = 128 + rank; it < 4864; it += nw) {
            if (it < 896) scan_item<64>(cx, p, l, it - 128);
            else if (it < 1280) scan_item<32>(cx, p, l, it - 896);
            else if (it < 2048) sample_rec_item<64>(cx, p, l, it - 1280);
            else if (it < 2816) sample_rec_item<32>(cx, p, l, it - 2048);
            else sample_s5_item(cx, p, l, it - 2816);
        }
        return;
    }
    const int TW = cx.G * 8;
    for (int it = cx.bid + cx.G * wid; it < 4864; it += TW) {
        if (it < 128) s5_scan_item(cx, p, l, it);
        else if (it < 896) scan_item<64>(cx, p, l, it - 128);
        else if (it < 1280) scan_item<32>(cx, p, l, it - 896);
        else if (it < 2048) sample_rec_item<64>(cx, p, l, it - 1280);
        else if (it < 2816) sample_rec_item<32>(cx, p, l, it - 2048);
        else sample_s5_item(cx, p, l, it - 2816);
    }
}

DEV void outproj_tile128(const Ctx cx, const P& p, int l, int ct, int kc, unsigned char* lds) {
    const int tid = cx.tid, lane = tid & 63, wid = tid >> 6, wr = wid >> 1, wc = wid & 1, fr = lane & 15, fq = lane >> 4;
    const bf16_t* MIX = (const bf16_t*)(p.ws + O_MIX) + kc * 256;
    const bf16_t* Bt = (const bf16_t*)(p.ws + O_BTOUT) + (size_t)l * D * D + kc * 256;
    float* PART = (float*)(p.ws + O_PART) + (size_t)kc * 128 * D;
    f32x4 acc[2][4];
    gemm128<2>(cx, MIX, D, Bt, D, TP, ct * 128, lds, acc);
#pragma unroll
    for (int mi = 0; mi < 2; ++mi)
#pragma unroll
        for (int ni = 0; ni < 4; ++ni)
            *(f32x4*)(PART + (size_t)(wr * 32 + mi * 16 + fr) * D + ct * 128 + wc * 64 + ni * 16 + 4 * fq) = acc[mi][ni];
}

DEV void sample_finalize(const Ctx cx, const P& p, int j) {
    const int lane = cx.tid & 63, wid = cx.tid >> 6, col = wid * 128 + lane * 2;
    const size_t row = (size_t)TP + j;
    bf16_t* AX = (bf16_t*)(p.ws + O_AX) + row * D + col;
    const float* PART = (const float*)(p.ws + O_PART) + (size_t)j * D + col;
    const unsigned w = *(const unsigned*)AX;
    float x0 = bflo(w), x1 = bfhi(w);
#pragma unroll
    for (int kc = 0; kc < 4; ++kc) { const f32x2_t q = *(const f32x2_t*)(PART + (size_t)kc * 128 * D); x0 += q[0]; x1 += q[1]; }
    *(unsigned*)AX = cvt_pk(x0, x1);
    const float ss = wave_sum(x0 * x0 + x1 * x1);
    float* RSQ = (float*)(p.ws + O_RSQ) + row * 16;
    if (lane == 0) { RSQ[wid] = ss; RSQ[8 + wid] = 0.f; }
}

struct EpiOut {
    static constexpr bool PERM = true, AFTER_DRAIN = false;
    const P* p; int l;
    DEV void operator()(const f32x4 (&acc)[2][2][4][2], const pg8::Unit& u, int wr, int wc, int fr, int fq) const {
        bf16_t* AX = (bf16_t*)(p->ws + O_AX); float* RSQ = (float*)(p->ws + O_RSQ);
#pragma unroll
        for (int ai = 0; ai < 2; ++ai) {
            u32x4 rw[4][2];
#pragma unroll
            for (int m = 0; m < 4; ++m)
#pragma unroll
                for (int bj = 0; bj < 2; ++bj)
                    rw[m][bj] = *(const u32x4*)(AX + (size_t)(u.pm * 256 + ai * 128 + wr * 64 + m * 16 + fr) * D + u.pn * 256 + bj * 128 + wc * 32 + 8 * fq);
#pragma unroll
            for (int m = 0; m < 4; ++m) {
                const int row = u.pm * 256 + ai * 128 + wr * 64 + m * 16 + fr;
                float ss = 0.f;
#pragma unroll
                for (int bj = 0; bj < 2; ++bj) {
                    const int col = u.pn * 256 + bj * 128 + wc * 32 + 8 * fq;
                    const u32x4 w = rw[m][bj];
                    f32x4 x0 = acc[ai][bj][m][0], x1 = acc[ai][bj][m][1];
                    x0[0] += bflo(w.x); x0[1] += bfhi(w.x); x0[2] += bflo(w.y); x0[3] += bfhi(w.y);
                    x1[0] += bflo(w.z); x1[1] += bfhi(w.z); x1[2] += bflo(w.w); x1[3] += bfhi(w.w);
                    u32x4 o; o.x = cvt_pk(x0[0], x0[1]); o.y = cvt_pk(x0[2], x0[3]); o.z = cvt_pk(x1[0], x1[1]); o.w = cvt_pk(x1[2], x1[3]);
                    *(u32x4*)(AX + (size_t)row * D + col) = o;
                    ss += (x0[0] * x0[0] + x0[1] * x0[1]) + (x0[2] * x0[2] + x0[3] * x0[3]) + (x1[0] * x1[0] + x1[1] * x1[1]) + (x1[2] * x1[2] + x1[3] * x1[3]);
                }
                ss += __shfl_xor(ss, 16); ss += __shfl_xor(ss, 32);
                if (fq == 0) RSQ[row * 16 + u.pn * 4 + wc] = ss;
            }
        }
    }
};

struct EpiFinal {
    static constexpr bool PERM = true, AFTER_DRAIN = true;
    const P* p;
    DEV void fused(f32x4 (&acc)[2][2][4][2], const pg8::Unit& u, int wr, int wc, int fr, int fq, PG8_LAS unsigned char* lds, int wid, int lane) const {
        const bf16_t* AX = (const bf16_t*)(p->ws + O_AX);
        PG8_LAS float* Pt = (PG8_LAS float*)lds;
        PG8_LAS float* St = (PG8_LAS float*)(lds + 8192);
        float* X = (float*)(p->ws + O_FX); unsigned* cnt = (unsigned*)(p->ws + O_FCNT) + 64 * u.pm;
#pragma unroll
        for (int ai = 0; ai < 2; ++ai) {
            u32x4 rw[4][2];
#pragma unroll
            for (int m = 0; m < 4; ++m)
#pragma unroll
                for (int bj = 0; bj < 2; ++bj)
                    rw[m][bj] = *(const u32x4*)(AX + (size_t)(u.pm * 256 + ai * 128 + wr * 64 + m * 16 + fr) * D + u.pn * 256 + bj * 128 + wc * 32 + 8 * fq);
#pragma unroll
            for (int m = 0; m < 4; ++m) {
                float ss = 0.f;
#pragma unroll
                for (int bj = 0; bj < 2; ++bj) {
                    const u32x4 w = rw[m][bj];
                    f32x4 x0 = acc[ai][bj][m][0], x1 = acc[ai][bj][m][1];
                    x0[0] += bflo(w.x); x0[1] += bfhi(w.x); x0[2] += bflo(w.y); x0[3] += bfhi(w.y);
                    x1[0] += bflo(w.z); x1[1] += bfhi(w.z); x1[2] += bflo(w.w); x1[3] += bfhi(w.w);
                    acc[ai][bj][m][0] = x0; acc[ai][bj][m][1] = x1;
                    ss += (x0[0] * x0[0] + x0[1] * x0[1]) + (x0[2] * x0[2] + x0[3] * x0[3]) + (x1[0] * x1[0] + x1[1] * x1[1]) + (x1[2] * x1[2] + x1[3] * x1[3]);
                }
                ss += __shfl_xor(ss, 16); ss += __shfl_xor(ss, 32);
                if (fq == 0) Pt[(ai * 128 + wr * 64 + m * 16 + fr) * 4 + wc] = ss;
            }
        }
        asm volatile("s_waitcnt lgkmcnt(0)" ::: "memory"); __builtin_amdgcn_s_barrier(); asm volatile("" ::: "memory");
        const int row = wid * 32 + (lane & 31);
        if (lane < 32) {
            const float tot = (Pt[row * 4 + 0] + Pt[row * 4 + 1]) + (Pt[row * 4 + 2] + Pt[row * 4 + 3]);
            __hip_atomic_store(X + ((size_t)(u.pm * 256 + row) * 4 + u.pn), tot, __ATOMIC_RELAXED, __HIP_MEMORY_SCOPE_AGENT);
        }
        asm volatile("s_waitcnt vmcnt(0)" ::: "memory");
        if (lane == 0) __hip_atomic_fetch_add(cnt, 1u, __ATOMIC_RELAXED, __HIP_MEMORY_SCOPE_AGENT);
        if (wid == 0) {
            unsigned spins = 0;
            while ((unsigned)__builtin_amdgcn_readfirstlane(__hip_atomic_load(cnt, __ATOMIC_RELAXED, __HIP_MEMORY_SCOPE_AGENT)) < 32u) { __builtin_amdgcn_s_sleep(2); if (++spins > (1u << 22)) break; }
            __builtin_amdgcn_fence(__ATOMIC_ACQUIRE, "agent");
        }
        asm volatile("s_waitcnt vmcnt(0) lgkmcnt(0)" ::: "memory"); __builtin_amdgcn_s_barrier(); asm volatile("" ::: "memory");
        if (lane < 32) {
            const float* sl = X + (size_t)(u.pm * 256 + row) * 4;
            float t = 0.f;
#pragma unroll
            for (int q = 0; q < 4; ++q) t += __hip_atomic_load(sl + q, __ATOMIC_RELAXED, __HIP_MEMORY_SCOPE_AGENT);
            St[row] = rsqrtf(t * (1.0f / 1024.0f) + EPS);
        }
        asm volatile("s_waitcnt lgkmcnt(0)" ::: "memory"); __builtin_amdgcn_s_barrier(); asm volatile("" ::: "memory");
        f32x4 gf[2][2];
#pragma unroll
        for (int bj = 0; bj < 2; ++bj)
#pragma unroll
            for (int n = 0; n < 2; ++n) gf[bj][n] = *(const f32x4*)(p->in[24] + u.pn * 256 + bj * 128 + wc * 32 + 8 * fq + 4 * n);
#pragma unroll
        for (int ai = 0; ai < 2; ++ai)
#pragma unroll
            for (int m = 0; m < 4; ++m) {
                const int r = ai * 128 + wr * 64 + m * 16 + fr; const float sc = St[r];
                float* y = p->out + (size_t)(u.pm * 256 + r) * D + u.pn * 256 + wc * 32 + 8 * fq;
#pragma unroll
                for (int bj = 0; bj < 2; ++bj)
#pragma unroll
                    for (int n = 0; n < 2; ++n) *(f32x4*)(y + bj * 128 + 4 * n) = acc[ai][bj][m][n] * sc * gf[bj][n];
            }
    }
};

DEV void sample_final(const Ctx cx, const P& p, int j, unsigned char* lds) {
    const int lane = cx.tid & 63, wid = cx.tid >> 6, col = wid * 128 + lane * 2;
    const size_t row = (size_t)TP + j;
    const bf16_t* AX = (const bf16_t*)(p.ws + O_AX) + row * D + col;
    const float* PART = (const float*)(p.ws + O_PART) + (size_t)j * D + col;
    const unsigned w = *(const unsigned*)AX;
    float x0 = bflo(w), x1 = bfhi(w);
#pragma unroll
    for (int kc = 0; kc < 4; ++kc) { const f32x2_t q = *(const f32x2_t*)(PART + (size_t)kc * 128 * D); x0 += q[0]; x1 += q[1]; }
    const float ss = wave_sum(x0 * x0 + x1 * x1);
    float* red = (float*)lds;
    __syncthreads();
    if (lane == 0) red[wid] = ss;
    __syncthreads();
    float t = 0.f;
#pragma unroll
    for (int q = 0; q < 8; ++q) t += red[q];
    const float sc = rsqrtf(t * (1.0f / 1024.0f) + EPS);
    const f32x2_t g = *(const f32x2_t*)(p.in[24] + col);
    f32x2_t y; y[0] = x0 * sc * g[0]; y[1] = x1 * sc * g[1];
    *(f32x2_t*)(p.out + row * D + col) = y;
}

DEV void phase_outproj(const Ctx cx, const P& p, int l, unsigned char* lds) {
    pg8::Gemm g{(const bf16_t*)(p.ws + O_MIX), (const bf16_t*)(p.ws + O_BTOUT) + (size_t)l * D * D, TP, D, D};
    pg8::StaticOrder S; S.init(TP, D, cx.G, cx.bid);
    if (l == 1 && cx.G == 256) {
        EpiFinal E{&p};
        pg8::gemm_phase<EpiFinal, pg8::StaticOrder>(cx.tid, (PG8_LAS unsigned char*)lds, g, S, E, nullptr);
        for (int j = cx.bid; j < TS; j += cx.G) sample_final(cx, p, j, lds);
        return;
    }
    EpiOut E{&p, l};
    pg8::gemm_phase<EpiOut, pg8::StaticOrder>(cx.tid, (PG8_LAS unsigned char*)lds, g, S, E, nullptr);
    for (int j = cx.bid; j < TS; j += cx.G) sample_finalize(cx, p, j);
}

DEV void phase_final(const Ctx cx, const P& p) {
    const int lane = cx.tid & 63, wid = cx.tid >> 6;
    const float* RSQ = (const float*)(p.ws + O_RSQ);
    const bf16_t* AX = (const bf16_t*)(p.ws + O_AX);
    f32x4 g[2][2];
#pragma unroll
    for (int i = 0; i < 2; ++i) { g[i][0] = *(const f32x4*)(p.in[24] + i * 512 + lane * 8); g[i][1] = *(const f32x4*)(p.in[24] + i * 512 + lane * 8 + 4); }
    for (int row0 = (cx.bid * 8 + wid) * 4; row0 < MT; row0 += cx.G * 32) {
        u32x4 w[4][2]; float qs[4];
#pragma unroll
        for (int rr = 0; rr < 4; ++rr) {
            const int row = row0 + rr;
            qs[rr] = (lane < 16) ? RSQ[row * 16 + lane] : 0.f;
#pragma unroll
            for (int i = 0; i < 2; ++i) w[rr][i] = *(const u32x4*)(AX + (size_t)row * D + i * 512 + lane * 8);
        }
#pragma unroll
        for (int rr = 0; rr < 4; ++rr) {
            const float r = rsqrtf(wave_sum(qs[rr]) * (1.0f / 1024.0f) + EPS);
            float* y = p.out + (size_t)(row0 + rr) * D;
#pragma unroll
            for (int i = 0; i < 2; ++i) {
                const u32x4 ww = w[rr][i]; const f32x4 g0 = g[i][0], g1 = g[i][1];
                f32x4 a, b;
                a[0] = bflo(ww.x) * r * g0[0]; a[1] = bfhi(ww.x) * r * g0[1]; a[2] = bflo(ww.y) * r * g0[2]; a[3] = bfhi(ww.y) * r * g0[3];
                b[0] = bflo(ww.z) * r * g1[0]; b[1] = bfhi(ww.z) * r * g1[1]; b[2] = bflo(ww.w) * r * g1[2]; b[3] = bfhi(ww.w) * r * g1[3];
                *(f32x4*)(y + i * 512 + lane * 8) = a; *(f32x4*)(y + i * 512 + lane * 8 + 4) = b;
            }
        }
    }
}

#define XB_TMO      128
#define XB_XCNT(j)  (256  + 64 * (j))
#define XB_XSUB(j)  (1280 + 64 * (j))
#define XB_XGEN(j)  (2304 + 64 * (j))
#define XB_TOP      3328
#define XB_TOPGEN   3392
#define XCD_BAR_WORDS 3456
#define XB_SPIN_CAP (1u << 18)
#define XB_LAS __attribute__((address_space(3)))

__device__ __forceinline__ unsigned xb_ld(unsigned* p)              { return __hip_atomic_load(p, __ATOMIC_RELAXED, __HIP_MEMORY_SCOPE_AGENT); }
__device__ __forceinline__ unsigned xb_add(unsigned* p, unsigned v) { return __hip_atomic_fetch_add(p, v, __ATOMIC_RELAXED, __HIP_MEMORY_SCOPE_AGENT); }
__device__ __forceinline__ unsigned xb_xcc_id() { return (unsigned)__builtin_amdgcn_s_getreg((3 << 11) | 20) & 0xFu; }
#define XB_SPIN(cond, bar) do { unsigned _sp = 0; while (cond) { __builtin_amdgcn_s_sleep(1); \
    if ((++_sp & 255u) == 0u) { if (xb_ld(&(bar)[XB_TMO])) break; if (_sp > XB_SPIN_CAP) { atomicAdd(&(bar)[XB_TMO], 1u); break; } } } } while (0)

struct XcdBarrier {
    unsigned* bar; unsigned x;
    volatile XB_LAS unsigned* st;
};

__device__ __forceinline__ XcdBarrier xcd_barrier_post(unsigned* bar, volatile XB_LAS unsigned* st) {
    XcdBarrier b; b.bar = bar; b.x = xb_xcc_id(); b.st = st;
    if (threadIdx.x == 0) (void)xb_add(&bar[XB_XCNT(b.x)], 1u);
    return b;
}
__device__ __forceinline__ void xcd_barrier_complete(unsigned* bar, unsigned x, unsigned& nloc, unsigned& nx) {
    const unsigned G = gridDim.x * gridDim.y * gridDim.z;
    unsigned sum, cnt, mine, sp = 0u;
    for (;;) {
        sum = 0u; cnt = 0u; mine = 0u;
#pragma unroll
        for (unsigned j = 0; j < 16; ++j) { const unsigned c = xb_ld(&bar[XB_XCNT(j)]); sum += c; cnt += (c > 0u) ? 1u : 0u; mine = (j == x) ? c : mine; }
        if (sum == G) break;
        __builtin_amdgcn_s_sleep(1);
        if ((++sp & 255u) == 0u) { if (xb_ld(&bar[XB_TMO])) break; if (sp > XB_SPIN_CAP) { atomicAdd(&bar[XB_TMO], 1u); break; } }
    }
    nloc = mine > 0u ? mine : 1u; nx = cnt > 0u ? cnt : 1u;
}

__device__ __forceinline__ void xcd_barrier(const XcdBarrier& b) {
    asm volatile("s_waitcnt vmcnt(0)" ::: "memory");
    __syncthreads();
    if (threadIdx.x == 0) {
        unsigned* bar = b.bar;
        __builtin_amdgcn_s_waitcnt(0);
        unsigned nloc = b.st[0], nx = b.st[1];
        if (nloc == 0u) { xcd_barrier_complete(bar, b.x, nloc, nx); b.st[0] = nloc; b.st[1] = nx; }
        const unsigned old = xb_add(&bar[XB_XSUB(b.x)], 1u);
        const unsigned gen = old / nloc;
        if (old + 1u == (gen + 1u) * nloc) {
            __builtin_amdgcn_fence(__ATOMIC_RELEASE, "agent");
            asm volatile("s_waitcnt vmcnt(0)" ::: "memory");
            const unsigned og = xb_add(&bar[XB_TOP], 1u);
            const unsigned tg = og / nx;
            if (og + 1u == (tg + 1u) * nx) xb_add(&bar[XB_TOPGEN], 1u);
            else XB_SPIN(xb_ld(&bar[XB_TOPGEN]) == tg, bar);
            __builtin_amdgcn_fence(__ATOMIC_ACQUIRE, "agent");
            xb_add(&bar[XB_XGEN(b.x)], 1u);
            asm volatile("s_waitcnt vmcnt(0)" ::: "memory");
        } else {
            XB_SPIN(xb_ld(&bar[XB_XGEN(b.x)]) == gen, bar);
            __builtin_amdgcn_fence(__ATOMIC_ACQUIRE, "agent");
            asm volatile("s_waitcnt vmcnt(0)" ::: "memory");
        }
    }
    __syncthreads();
}

DEV void grid_bar(unsigned* ctr, unsigned target) {
    asm volatile("s_waitcnt vmcnt(0) lgkmcnt(0)" ::: "memory");
    __syncthreads();
    if (threadIdx.x == 0) {
        __builtin_amdgcn_fence(__ATOMIC_RELEASE, "agent");
        asm volatile("s_waitcnt vmcnt(0)" ::: "memory");
        __hip_atomic_fetch_add(ctr, 1u, __ATOMIC_RELAXED, __HIP_MEMORY_SCOPE_AGENT);
        unsigned spins = 0;
        while (__hip_atomic_load(ctr, __ATOMIC_RELAXED, __HIP_MEMORY_SCOPE_AGENT) < target) { __builtin_amdgcn_s_sleep(1); if (++spins > (1u << 24)) break; }
        __builtin_amdgcn_fence(__ATOMIC_ACQUIRE, "agent");
        asm volatile("s_waitcnt vmcnt(0)" ::: "memory");
    }
    __syncthreads();
}

__global__ void __launch_bounds__(NTHR) hymba_fwd(P p) {
    __shared__ __attribute__((aligned(16))) unsigned char lds[LDS_BYTES];
    cg::grid_group grid = cg::this_grid();
    if (blockIdx.x == 0 && p.ph_lo == 0) for (int i = threadIdx.x; i < 3456; i += NTHR) __hip_atomic_store((unsigned*)(p.ws + O_XBAR) + i, 0u, __ATOMIC_RELAXED, __HIP_MEMORY_SCOPE_AGENT);
    if (blockIdx.x == 1 && p.ph_lo == 0 && threadIdx.x < 64) __hip_atomic_store((unsigned*)(p.ws + O_FCNT) + 64 * threadIdx.x, 0u, __ATOMIC_RELAXED, __HIP_MEMORY_SCOPE_AGENT);
    volatile XB_LAS unsigned* xst = (volatile XB_LAS unsigned*)(lds + LDS_BYTES - 16);
    if (threadIdx.x < 4) xst[threadIdx.x] = 0u;
    __syncthreads();
    int nbar = 0;
    for (int ph = p.ph_lo; ph < p.ph_hi; ++ph) {
        if (ph == 0) { grid.sync(); (void)xcd_barrier_post((unsigned*)(p.ws + O_XBAR), (volatile XB_LAS unsigned*)(lds + LDS_BYTES - 16)); }
        Ctx cx; { int t_ = threadIdx.x, b_ = blockIdx.x, g_ = gridDim.x; asm volatile("" : "+v"(t_)); asm volatile("" : "+s"(b_)); asm volatile("" : "+s"(g_)); cx.tid = t_; cx.bid = b_; cx.G = g_; }
#ifndef PHMASK
#define PHMASK 0xff
#endif
        if (ph == 0) { if (PHMASK & 1) phase_prep(cx, p, lds, (cx.G == 256) ? 0 : 2, cx.bid, cx.G); }
        else if (ph == NPHASE - 1) { if ((PHMASK & 2) && cx.G != 256) phase_final(cx, p); }
        else {
            const int l = (ph - 1) / 6, s = (ph - 1) % 6;
#ifndef REPMASK
#define REPMASK 0
#endif
            if (s == 0) { if (PHMASK & 4) phase_inproj(cx, p, l, lds); if (REPMASK & 1) phase_inproj(cx, p, l, lds); }
            else if (s == 1) { if (PHMASK & 8) phase_b1(cx, p, l, lds); if (REPMASK & 2) phase_b1(cx, p, l, lds); }
            else if (s == 2) { if (PHMASK & 16) phase_b2(cx, p, l, lds); }
            else if (s == 3) { if (PHMASK & 32) phase_b3(cx, p, l, lds); if (REPMASK & 4) phase_b3(cx, p, l, lds); }
            else if (s == 4) { if (PHMASK & 64) phase_b4(cx, p, l, lds); if (REPMASK & 64) phase_b4(cx, p, l, lds); }
            else { if (PHMASK & 128) phase_outproj(cx, p, l, lds); if ((REPMASK & 128) && l == 0) phase_outproj(cx, p, l, lds); }
        }
        if (ph + 1 < p.ph_hi && !(ph + 1 == NPHASE - 1 && gridDim.x == 256)) {
            XcdBarrier b; b.bar = (unsigned*)(p.ws + O_XBAR); b.x = xb_xcc_id(); b.st = (volatile XB_LAS unsigned*)(lds + LDS_BYTES - 16);
            xcd_barrier(b);
        }
    }
#ifdef STOPAT
    grid.sync();
    {
        const int lane = threadIdx.x & 63, wid = threadIdx.x >> 6;
        const int nchunk = (int)(O_END / 65536);
        for (int c = blockIdx.x * 8 + wid; c < nchunk; c += gridDim.x * 8) {
            const unsigned* w = (const unsigned*)(p.ws + (size_t)c * 65536);
            unsigned sum = 0;
            for (int i = lane; i < 16384; i += 64) sum += w[i] * (unsigned)(i * 2 + 1);
            for (int o = 32; o >= 1; o >>= 1) sum += __shfl_xor(sum, o);
            if (lane == 0) p.out[c] = (float)(sum & 0xffffffu);
        }
    }
#endif
}

extern "C" void kernel_launch(void* const* d_in, const int* in_sizes, int n_in, void* d_out, int out_size, void* d_ws, size_t ws_size, hipStream_t stream) {
    static int grid_blocks = 0;
    if (grid_blocks == 0) {
        if (n_in != 25 || ws_size < O_END) { fprintf(stderr, "kernel_launch: unexpected n_in %d or workspace %zu < %zu\n", n_in, ws_size, (size_t)O_END); grid_blocks = -1; return; }
        int dev = 0, cus = 0, per_cu = 0;
        (void)hipGetDevice(&dev);
        (void)hipDeviceGetAttribute(&cus, hipDeviceAttributeMultiprocessorCount, dev);
        (void)hipOccupancyMaxActiveBlocksPerMultiprocessor(&per_cu, (const void*)hymba_fwd, NTHR, 0);
        if (per_cu < 1) { fprintf(stderr, "kernel_launch: occupancy query gave %d\n", per_cu); per_cu = 1; }
        grid_blocks = cus * 1;
        (void)hipGetLastError();
    }
    if (grid_blocks < 0) return;
    P p{};
    for (int i = 0; i < 25; ++i) p.in[i] = (const float*)d_in[i];
    p.out = (float*)d_out; p.ws = (unsigned char*)d_ws;
#if MEGA
#ifdef STOPAT
    p.ph_lo = 0; p.ph_hi = STOPAT;
#else
    p.ph_lo = 0; p.ph_hi = NPHASE;
#endif
    void* args[] = {&p};
    hipError_t e = hipLaunchCooperativeKernel((const void*)hymba_fwd, dim3(grid_blocks), dim3(NTHR), args, 0, stream);
    if (e != hipSuccess) fprintf(stderr, "cooperative launch failed: %s (grid %d)\n", hipGetErrorString(e), grid_blocks);
#else
    for (int ph = 0; ph < NPHASE; ++ph) {
        p.ph_lo = ph; p.ph_hi = ph + 1;
        hipLaunchKernelGGL(hymba_fwd, dim3(grid_blocks), dim3(NTHR), 0, stream, p);
    }
#endif
}
```
